# Optimizing an MI355X kernel written in HIP

```python
import jax
import jax.numpy as jnp
from jax import lax
import numpy as np

D_MODEL = 1024
BATCH = 8
SEQ = 4096
DEPTH = 4

N_MIXERS = 3
N_HEADS = 16
HEAD_DIM = D_MODEL // N_HEADS
CONV_WIDTH = 3
Q_BLOCK = 128
N_EXPERTS = 32
TOP_K = 4
D_EXPERT = D_MODEL
SWIGLU_LIMIT = 7.0
SWIGLU_ALPHA = 1.702
PLE_DIM = 256
EXPERT_ROW_BLOCK = 512
LN_EPS = 1e-5
DEEPNORM_ALPHA = (2 * DEPTH) ** 0.25
DEEPNORM_BETA = (8 * DEPTH) ** -0.25
FOX_GATE_BIAS = 3.0

kernel_name = 'hybrid_conv_stickbreak_fox_moe'


def layer_norm(x, g, b):
    xf = x.astype(jnp.float32)
    mu = jnp.mean(xf, axis=-1, keepdims=True)
    var = jnp.mean(jnp.square(xf - mu), axis=-1, keepdims=True)
    y = (xf - mu) * lax.rsqrt(var + LN_EPS)
    return (y * g.astype(jnp.float32) + b.astype(jnp.float32)).astype(x.dtype)


def split_heads(t):
    bsz, s, _ = t.shape
    return t.reshape(bsz, s, N_HEADS, HEAD_DIM)


def short_conv_mixer(x, w_in, w_conv, w_out):
    s = x.shape[1]
    gate_b, gate_c, h = jnp.split(x @ w_in, 3, axis=-1)
    u = jnp.pad(gate_c * h, ((0, 0), (CONV_WIDTH - 1, 0), (0, 0)))
    conv = sum(w_conv[k] * u[:, k:k + s] for k in range(CONV_WIDTH))
    return (gate_b * conv) @ w_out


def stick_breaking_mixer(x, w_in, w_out):
    bsz, s, d = x.shape
    q, k, v = (split_heads(t) for t in jnp.split(x @ w_in, 3, axis=-1))
    scale = HEAD_DIM ** -0.5
    outs = []
    for q0 in range(0, s, Q_BLOCK):
        q1 = q0 + Q_BLOCK
        z = jnp.einsum('bqhd,bkhd->bhqk', q[:, q0:q1], k[:, :q1],
                       preferred_element_type=jnp.float32) * scale
        t_pos = jnp.arange(q0, q1)[:, None]
        s_pos = jnp.arange(q1)[None, :]
        strict = s_pos < t_pos
        log_not = jnp.where(strict, -jax.nn.softplus(z), 0.0)
        between = lax.cumsum(log_not, axis=3, reverse=True) - log_not
        w = jnp.where(strict, jnp.exp(jax.nn.log_sigmoid(z) + between), 0.0)
        outs.append(jnp.einsum('bhqk,bkhd->bqhd', w.astype(v.dtype), v[:, :q1]))
    o = jnp.concatenate(outs, axis=1).reshape(bsz, s, d)
    return o @ w_out


def forgetting_attention_mixer(x, w_in, b_f, w_out):
    bsz, s, d = x.shape
    proj = x @ w_in
    q, k, v = (split_heads(t) for t in jnp.split(proj[..., :3 * d], 3, axis=-1))
    log_f = jax.nn.log_sigmoid(proj[..., 3 * d:].astype(jnp.float32) + b_f.astype(jnp.float32))
    cum = jnp.swapaxes(jnp.cumsum(log_f, axis=1), 1, 2)
    scale = HEAD_DIM ** -0.5
    outs = []
    for q0 in range(0, s, Q_BLOCK):
        q1 = q0 + Q_BLOCK
        z = jnp.einsum('bqhd,bkhd->bhqk', q[:, q0:q1], k[:, :q1],
                       preferred_element_type=jnp.float32) * scale
        z = z + cum[:, :, q0:q1, None] - cum[:, :, None, :q1]
        causal = jnp.arange(q1)[None, :] <= jnp.arange(q0, q1)[:, None]
        probs = jax.nn.softmax(jnp.where(causal, z, -jnp.inf), axis=-1)
        outs.append(jnp.einsum('bhqk,bkhd->bqhd', probs.astype(v.dtype), v[:, :q1]))
    o = jnp.concatenate(outs, axis=1).reshape(bsz, s, d)
    return o @ w_out


def clamped_swiglu(h_gate, h_up):
    h_gate = jnp.minimum(h_gate, SWIGLU_LIMIT)
    h_up = jnp.clip(h_up, -SWIGLU_LIMIT, SWIGLU_LIMIT)
    return h_gate * jax.nn.sigmoid(SWIGLU_ALPHA * h_gate) * (h_up + 1.0)


def moe_ffn(x2d, w_router, b_router, w_gate, b_gate, w_up, b_up, w_down, b_down):
    n_tok, d = x2d.shape
    logits = (x2d @ w_router).astype(jnp.float32) + b_router.astype(jnp.float32)
    top_logit, top_e = lax.top_k(logits, TOP_K)
    gate = jax.nn.softmax(top_logit, axis=-1)
    n_slots = n_tok * TOP_K
    flat_e = top_e.reshape(-1)
    flat_tok = jnp.repeat(jnp.arange(n_tok, dtype=jnp.int32), TOP_K)
    order = jnp.argsort(flat_e)
    se, stok, sgate = flat_e[order], flat_tok[order], gate.reshape(-1)[order]
    counts = jnp.bincount(flat_e, length=N_EXPERTS)
    padded = (counts + EXPERT_ROW_BLOCK - 1) // EXPERT_ROW_BLOCK * EXPERT_ROW_BLOCK
    start = jnp.cumsum(counts) - counts
    pend = jnp.cumsum(padded)
    pstart = pend - padded
    dest = pstart[se] + jnp.arange(n_slots) - start[se]
    n_blocks = -(-n_slots // EXPERT_ROW_BLOCK) + N_EXPERTS
    n_rows = n_blocks * EXPERT_ROW_BLOCK
    row_tok = jnp.zeros((n_rows,), jnp.int32).at[dest].set(stok)
    row_gate = jnp.zeros((n_rows,), jnp.float32).at[dest].set(sgate)
    block_start = jnp.arange(n_blocks) * EXPERT_ROW_BLOCK
    block_e = jnp.minimum(jnp.sum(pend[None, :] <= block_start[:, None], axis=1), N_EXPERTS - 1)

    def expert_block(args):
        tok, g, e = args
        xb = x2d[tok]
        a = clamped_swiglu(xb @ w_gate[e] + b_gate[e], xb @ w_up[e] + b_up[e])
        return (a @ w_down[e] + b_down[e]) * g[:, None].astype(x2d.dtype)

    out = lax.map(expert_block, (row_tok.reshape(n_blocks, EXPERT_ROW_BLOCK),
                                 row_gate.reshape(n_blocks, EXPERT_ROW_BLOCK), block_e))
    return jax.ops.segment_sum(out.reshape(n_rows, d), row_tok, num_segments=n_tok)


def setup_inputs(seed: int = 0) -> dict:
    key = jax.random.key(seed)
    ks = jax.random.split(key, 25)
    d, f, h, e = D_MODEL, D_EXPERT, N_HEADS, N_EXPERTS
    n_a = len(range(0, DEPTH, N_MIXERS))
    n_b = len(range(1, DEPTH, N_MIXERS))
    n_c = len(range(2, DEPTH, N_MIXERS))

    def nrm(k, shape, s):
        return jax.random.normal(k, shape, jnp.float32) * s

    return {
        'x': nrm(ks[0], (BATCH, SEQ, d), 1.0),
        'p': nrm(ks[1], (DEPTH, BATCH, SEQ, PLE_DIM), 1.0),
        'conv_w_in': nrm(ks[2], (n_a, d, 3 * d), d ** -0.5),
        'conv_w': nrm(ks[3], (n_a, CONV_WIDTH, d), CONV_WIDTH ** -0.5),
        'conv_w_out': nrm(ks[4], (n_a, d, d), d ** -0.5 * DEEPNORM_BETA),
        'sb_w_in': nrm(ks[5], (n_b, d, 3 * d), d ** -0.5),
        'sb_w_out': nrm(ks[6], (n_b, d, d), d ** -0.5 * DEEPNORM_BETA),
        'fox_w_in': nrm(ks[7], (n_c, d, 3 * d + h), d ** -0.5),
        'fox_b_f': FOX_GATE_BIAS + nrm(ks[8], (n_c, h), 0.5),
        'fox_w_out': nrm(ks[9], (n_c, d, d), d ** -0.5 * DEEPNORM_BETA),
        'ln1_g': 1.0 + nrm(ks[10], (DEPTH, d), 0.02),
        'ln1_b': nrm(ks[11], (DEPTH, d), 0.02),
        'ln2_g': 1.0 + nrm(ks[12], (DEPTH, d), 0.02),
        'ln2_b': nrm(ks[13], (DEPTH, d), 0.02),
        'router_w': nrm(ks[14], (DEPTH, d, e), d ** -0.5),
        'router_b': nrm(ks[15], (DEPTH, e), 0.01),
        'exp_w_gate': nrm(ks[16], (DEPTH, e, d, f), d ** -0.5),
        'exp_b_gate': nrm(ks[17], (DEPTH, e, f), 0.01),
        'exp_w_up': nrm(ks[18], (DEPTH, e, d, f), d ** -0.5),
        'exp_b_up': nrm(ks[19], (DEPTH, e, f), 0.01),
        'exp_w_down': nrm(ks[20], (DEPTH, e, f, d), f ** -0.5 * DEEPNORM_BETA),
        'exp_b_down': nrm(ks[21], (DEPTH, e, d), 0.01),
        'ple_w_proj': nrm(ks[22], (DEPTH, PLE_DIM, d), PLE_DIM ** -0.5 * DEEPNORM_BETA),
        'ple_w_gate': nrm(ks[23], (DEPTH, d, d), d ** -0.5),
        'ple_b_gate': nrm(ks[24], (DEPTH, d), 0.01),
    }


def reference(x, p, conv_w_in, conv_w, conv_w_out, sb_w_in, sb_w_out, fox_w_in, fox_b_f, fox_w_out,
              ln1_g, ln1_b, ln2_g, ln2_b, router_w, router_b, exp_w_gate, exp_b_gate, exp_w_up,
              exp_b_up, exp_w_down, exp_b_down, ple_w_proj, ple_w_gate, ple_b_gate):
    bsz, s, d = x.shape
    for i in range(DEPTH):
        kind, j = i % N_MIXERS, i // N_MIXERS
        if kind == 0:
            mix = short_conv_mixer(x, conv_w_in[j], conv_w[j], conv_w_out[j])
        elif kind == 1:
            mix = stick_breaking_mixer(x, sb_w_in[j], sb_w_out[j])
        else:
            mix = forgetting_attention_mixer(x, fox_w_in[j], fox_b_f[j], fox_w_out[j])
        x = layer_norm(DEEPNORM_ALPHA * x + mix, ln1_g[i], ln1_b[i])
        ffn = moe_ffn(x.reshape(bsz * s, d), router_w[i], router_b[i], exp_w_gate[i], exp_b_gate[i],
                      exp_w_up[i], exp_b_up[i], exp_w_down[i], exp_b_down[i]).reshape(bsz, s, d)
        x = layer_norm(DEEPNORM_ALPHA * x + ffn, ln2_g[i], ln2_b[i])
        x = x + (p[i] @ ple_w_proj[i]) * jax.nn.sigmoid(x @ ple_w_gate[i] + ple_b_gate[i])
    return x
```

```cpp
#include <hip/hip_runtime.h>
#include <cstdio>
#include <cstdint>

#ifndef MK_PER_PHASE
#define MK_PER_PHASE 0
#endif

__device__ __forceinline__ int lane_id_() { int l; asm volatile("v_mbcnt_lo_u32_b32 %0, -1, 0\n\tv_mbcnt_hi_u32_b32 %0, -1, %0" : "=v"(l)); return l; }
__device__ __forceinline__ int tid_of(int wave) { return wave * 64 + lane_id_(); }

namespace pg8 {
#define PG8_LAS __attribute__((address_space(3)))
typedef unsigned short bf16_t;
typedef short bf16x8 __attribute__((ext_vector_type(8)));
typedef float f32x4 __attribute__((ext_vector_type(4)));
typedef float f32x2 __attribute__((ext_vector_type(2)));
typedef unsigned u32x4 __attribute__((ext_vector_type(4)));
typedef unsigned u32x2 __attribute__((ext_vector_type(2)));
typedef int i32x4 __attribute__((ext_vector_type(4)));
typedef int i32x8 __attribute__((ext_vector_type(8)));
constexpr int BM = 256, BK = 64, HALF = 128, HTB = HALF * BK * 2  , STAGE_BYTES = 8 * HTB, NXCD = 8, WGM = 8;

__host__ __device__ __forceinline__ int lds_byte(int r, int c) { const int st = (r >> 4) * 2 + (c >> 5), rr = r & 15, cc = c & 31, ob = rr * 64 + cc * 2; return st * 1024 + (ob ^ (((ob >> 9) & 1) << 5)); }
__host__ __device__ __forceinline__ void stage_rc(int b, int& R, int& C) { const int st = b / 1024, sb = b % 1024, swz = sb ^ (((sb >> 9) & 1) << 5); R = (st >> 1) * 16 + swz / 64; C = (st & 1) * 32 + (swz % 64) / 2; }
__host__ __device__ __forceinline__ int perm32(int rho) { const int n = rho >> 4, i = rho & 15; return 8 * (i >> 2) + 4 * n + (i & 3); }

struct Unit { int pm, pn, e; };
struct Gemm { const bf16_t* A; const bf16_t* Bt; int K; size_t bstride; };

struct StaticOrder {
    int nM, nN, nwg, G, c;
    __device__ __forceinline__ void init(int M, int N, int G_, int c_) { nM = M / BM; nN = N / BM; nwg = nM * nN; G = G_; c = c_; }
    __device__ __forceinline__ bool map(int i, Unit& u) const {
        const long L = (long)i * G + c; if (L >= nwg) return false;
        int wgid = (int)L; { const int q = nwg / NXCD, r = nwg % NXCD, xcd = wgid % NXCD, off = wgid / NXCD; wgid = (xcd < r ? xcd * (q + 1) : r * (q + 1) + (xcd - r) * q) + off; }
        const int nig = WGM * nN, gid = wgid / nig, fm = gid * WGM, gsz = (nM - fm) < WGM ? (nM - fm) : WGM;
        u.pm = fm + ((wgid % nig) % gsz); u.pn = (wgid % nig) / gsz; return true;
    }
    __device__ __forceinline__ bool next(int i, Unit& u) const { u.e = 0; return map(i, u); }
};
struct MoeOrder {
    StaticOrder so; const PG8_LAS int* tend;
    __device__ __forceinline__ void init(int ntiles, int N, int G_, int c_, const PG8_LAS int* tend_lane) { so.nM = ntiles; so.nN = N / BM; so.nwg = so.nM * so.nN; so.G = G_; so.c = c_; tend = tend_lane; }
    __device__ __forceinline__ bool next(int i, Unit& u) const {
        if (!so.map(i, u)) return false;
        const int te = tend[0];
        const unsigned long long bal = __ballot(te <= u.pm);
        u.e = __builtin_popcount((unsigned)(bal & 0xffffffffull)); if (u.e > 31) u.e = 31;
        return true;
    }
};

__device__ __forceinline__ unsigned cvt_pk_bf16(float lo, float hi) { unsigned r; asm volatile("v_cvt_pk_bf16_f32 %0, %1, %2" : "=v"(r) : "v"(lo), "v"(hi)); return r; }
__device__ __forceinline__ float bf_lo(unsigned w) { return __uint_as_float(w << 16); }
__device__ __forceinline__ float bf_hi(unsigned w) { return __uint_as_float(w & 0xffff0000u); }
__device__ __forceinline__ float sigmoidf_fast(float v) { return __builtin_amdgcn_rcpf(1.0f + __builtin_amdgcn_exp2f(-1.4426950408889634f * v)); }

struct EpiBf16 {
    static constexpr bool PERM = true;
    bf16_t* O; int ldc; int split_cols; size_t split_stride; float scale0;
    __device__ __forceinline__ void operator()(const f32x4 (&acc)[2][2][4][2], const Unit& u, int wr, int wc, int fr, int fq) const {
        const int row0 = u.pm * BM + wr * 64 + fr; int colt = u.pn * BM; bf16_t* base = O;
        float sc = 1.f; if (split_cols) { const int t = colt / split_cols; base += (size_t)t * split_stride; colt -= t * split_cols; if (t == 0) sc = scale0; }
        const int col0 = colt + wc * 64 + 8 * fq;
#pragma unroll
        for (int ai = 0; ai < 2; ++ai)
#pragma unroll
            for (int m = 0; m < 4; ++m) { bf16_t* rowp = base + (size_t)(row0 + ai * HALF + m * 16) * ldc + col0;
#pragma unroll
                for (int bj = 0; bj < 2; ++bj) { f32x4 v0 = acc[ai][bj][m][0] * sc, v1 = acc[ai][bj][m][1] * sc;
                    u32x4 w; w.x = cvt_pk_bf16(v0[0], v0[1]); w.y = cvt_pk_bf16(v0[2], v0[3]); w.z = cvt_pk_bf16(v1[0], v1[1]); w.w = cvt_pk_bf16(v1[2], v1[3]);
                    *(u32x4*)(rowp + bj * 32) = w; } }
    }
};
struct EpiResBf16 {
    static constexpr bool PERM = true;
    const bf16_t* res; bf16_t* out; int ldc; float alpha;
    __device__ __forceinline__ void operator()(const f32x4 (&acc)[2][2][4][2], const Unit& u, int wr, int wc, int fr, int fq) const {
        const int row0 = u.pm * BM + wr * 64 + fr, col0 = u.pn * BM + wc * 64 + 8 * fq;
#pragma unroll
        for (int ai = 0; ai < 2; ++ai)
#pragma unroll
            for (int m = 0; m < 4; ++m) { const size_t off = (size_t)(row0 + ai * HALF + m * 16) * ldc + col0;
#pragma unroll
                for (int bj = 0; bj < 2; ++bj) { const u32x4 r = *(const u32x4*)(res + off + bj * 32); const f32x4 a0 = acc[ai][bj][m][0], a1 = acc[ai][bj][m][1];
                    u32x4 w; w.x = cvt_pk_bf16(bf_lo(r.x) * alpha + a0[0], bf_hi(r.x) * alpha + a0[1]); w.y = cvt_pk_bf16(bf_lo(r.y) * alpha + a0[2], bf_hi(r.y) * alpha + a0[3]);
                    w.z = cvt_pk_bf16(bf_lo(r.z) * alpha + a1[0], bf_hi(r.z) * alpha + a1[1]); w.w = cvt_pk_bf16(bf_lo(r.w) * alpha + a1[2], bf_hi(r.w) * alpha + a1[3]);
                    *(u32x4*)(out + off + bj * 32) = w; }
                asm volatile("" ::: "memory"); }
    }
};
struct EpiRouter {
    static constexpr bool PERM = false;
    float* out;
    __device__ __forceinline__ void operator()(const f32x4 (&acc)[2][2][4][2], const Unit& u, int wr, int wc, int fr, int fq) const {
        if (wc != 0 || u.pn != 0) return;
        const int row0 = u.pm * BM + wr * 64 + fr;
#pragma unroll
        for (int ai = 0; ai < 2; ++ai)
#pragma unroll
            for (int m = 0; m < 4; ++m) { float* rowp = out + (size_t)(row0 + ai * HALF + m * 16) * 32 + 4 * fq;
                *(f32x4*)(rowp) = acc[ai][0][m][0]; *(f32x4*)(rowp + 16) = acc[ai][0][m][1]; }
    }
};
__device__ __forceinline__ unsigned pk4_fp8(float a, float b, float c, float d) { int w = 0; w = __builtin_amdgcn_cvt_pk_fp8_f32(a, b, w, false); w = __builtin_amdgcn_cvt_pk_fp8_f32(c, d, w, true); return (unsigned)w; }
struct EpiSwiglu {
    static constexpr bool PERM = true;
    unsigned char* H; const float* bg; const float* bu; float inv_scale;
    __device__ __forceinline__ void operator()(const f32x4 (&acc)[2][2][4][2], const Unit& u, int wr, int wc, int fr, int fq) const {
        const int row0 = u.pm * BM + wr * 64 + fr, ch0 = u.pn * HALF + wc * 32 + 8 * fq;
        f32x4 gb[2], ub[2];
#pragma unroll
        for (int n = 0; n < 2; ++n) { gb[n] = *(const f32x4*)(bg + (size_t)u.e * 1024 + ch0 + 4 * n); ub[n] = *(const f32x4*)(bu + (size_t)u.e * 1024 + ch0 + 4 * n); }
#pragma unroll
        for (int ai = 0; ai < 2; ++ai)
#pragma unroll
            for (int m = 0; m < 4; ++m) { unsigned char* rowp = H + (size_t)(row0 + ai * HALF + m * 16) * 1024 + ch0; float a[8];
#pragma unroll
                for (int n = 0; n < 2; ++n) { const f32x4 g4 = acc[ai][0][m][n] * inv_scale + gb[n], u4 = acc[ai][1][m][n] * inv_scale + ub[n];
#pragma unroll
                    for (int j = 0; j < 4; ++j) { const float g = fminf(g4[j], 7.0f), uu = fminf(fmaxf(u4[j], -7.0f), 7.0f); a[4 * n + j] = g * sigmoidf_fast(1.702f * g) * (uu + 1.0f); } }
                u32x2 w; w.x = pk4_fp8(a[0], a[1], a[2], a[3]); w.y = pk4_fp8(a[4], a[5], a[6], a[7]);
                *(u32x2*)rowp = w; }
    }
};
struct EpiDown {
    static constexpr bool PERM = true;
    unsigned char* Y; const float* bd; const float* rgate; float inv_scale, yscale;
    __device__ __forceinline__ void operator()(const f32x4 (&acc)[2][2][4][2], const Unit& u, int wr, int wc, int fr, int fq) const {
        const int row0 = u.pm * BM + wr * 64 + fr, col0 = u.pn * BM + wc * 64 + 8 * fq;
        f32x4 bv[2][2];
#pragma unroll
        for (int bj = 0; bj < 2; ++bj)
#pragma unroll
            for (int n = 0; n < 2; ++n) bv[bj][n] = *(const f32x4*)(bd + (size_t)u.e * 1024 + col0 + bj * 32 + 4 * n);
#pragma unroll
        for (int ai = 0; ai < 2; ++ai)
#pragma unroll
            for (int m = 0; m < 4; ++m) { const int row = row0 + ai * HALF + m * 16; const float gt = rgate[row] * yscale; unsigned char* rowp = Y + (size_t)row * 1024 + col0;
#pragma unroll
                for (int bj = 0; bj < 2; ++bj) { const f32x4 v0 = (acc[ai][bj][m][0] * inv_scale + bv[bj][0]) * gt, v1 = (acc[ai][bj][m][1] * inv_scale + bv[bj][1]) * gt;
                    u32x2 w; w.x = pk4_fp8(v0[0], v0[1], v0[2], v0[3]); w.y = pk4_fp8(v1[0], v1[1], v1[2], v1[3]);
                    *(u32x2*)(rowp + bj * 32) = w; } }
    }
};
struct EpiPle {
    static constexpr bool PERM = true;
    const bf16_t* xin; float* xout; bf16_t* xb; const bf16_t* pp; const float* bgate; float inv_scale;
    __device__ __forceinline__ void operator()(const f32x4 (&acc)[2][2][4][2], const Unit& u, int wr, int wc, int fr, int fq) const {
        const int row0 = u.pm * BM + wr * 64 + fr, col0 = u.pn * BM + wc * 64 + 8 * fq;
        f32x4 bv[2][2];
#pragma unroll
        for (int bj = 0; bj < 2; ++bj)
#pragma unroll
            for (int n = 0; n < 2; ++n) bv[bj][n] = *(const f32x4*)(bgate + col0 + bj * 32 + 4 * n);
#pragma unroll
        for (int ai = 0; ai < 2; ++ai)
#pragma unroll
            for (int m = 0; m < 4; ++m) { const size_t off = (size_t)(row0 + ai * HALF + m * 16) * 1024 + col0;
#pragma unroll
                for (int bj = 0; bj < 2; ++bj) { const size_t o2 = off + bj * 32;
                    const u32x4 xw = *(const u32x4*)(xin + o2); const f32x4 x0 = {bf_lo(xw.x), bf_hi(xw.x), bf_lo(xw.y), bf_hi(xw.y)}, x1 = {bf_lo(xw.z), bf_hi(xw.z), bf_lo(xw.w), bf_hi(xw.w)}; const u32x4 pw = *(const u32x4*)(pp + o2);
                    const f32x4 a0 = acc[ai][bj][m][0] * inv_scale + bv[bj][0], a1 = acc[ai][bj][m][1] * inv_scale + bv[bj][1];
                    f32x4 r0, r1;
                    r0[0] = x0[0] + bf_lo(pw.x) * sigmoidf_fast(a0[0]); r0[1] = x0[1] + bf_hi(pw.x) * sigmoidf_fast(a0[1]);
                    r0[2] = x0[2] + bf_lo(pw.y) * sigmoidf_fast(a0[2]); r0[3] = x0[3] + bf_hi(pw.y) * sigmoidf_fast(a0[3]);
                    r1[0] = x1[0] + bf_lo(pw.z) * sigmoidf_fast(a1[0]); r1[1] = x1[1] + bf_hi(pw.z) * sigmoidf_fast(a1[1]);
                    r1[2] = x1[2] + bf_lo(pw.w) * sigmoidf_fast(a1[2]); r1[3] = x1[3] + bf_hi(pw.w) * sigmoidf_fast(a1[3]);
                    if (xout) { *(f32x4*)(xout + o2) = r0; *(f32x4*)(xout + o2 + 4) = r1; }
                    u32x4 w; w.x = cvt_pk_bf16(r0[0], r0[1]); w.y = cvt_pk_bf16(r0[2], r0[3]); w.z = cvt_pk_bf16(r1[0], r1[1]); w.w = cvt_pk_bf16(r1[2], r1[3]);
                    *(u32x4*)(xb + o2) = w; }
                asm volatile("" ::: "memory"); }
    }
};

template <class Epi, class Sched, bool ALIGN_EPI, bool FP8 = false>
__device__ __forceinline__ void gemm_phase(PG8_LAS unsigned char* lds, const Gemm g, const Sched& S, const Epi& E, const int wave_) {
    int tid_ = tid_of(wave_); asm volatile("" : "+v"(tid_));
    const int tid = tid_, wid = __builtin_amdgcn_readfirstlane(tid >> 6), lane = tid & 63, wr = wid >> 2, wc = wid & 3, fr = lane & 15, fq = lane >> 4;
    constexpr int ES = FP8 ? 1 : 2;
    const int K = g.K, nt = K * ES / (BK * 2);
    unsigned voffA[2], voffB[2];
#pragma unroll
    for (int i = 0; i < 2; ++i) { int R, C; stage_rc(tid * 16 + i * 8192, R, C); const int Rb = Epi::PERM ? ((R & ~31) + perm32(R & 31)) : R;
        voffA[i] = (unsigned)(R * K * ES + C * 2); voffB[i] = (unsigned)((Epi::PERM ? ((Rb >> 5) * 64 + (Rb & 31)) : Rb) * K * ES + C * 2); }
    const size_t kstep = (size_t)(BK * 2);
    const size_t hstep = (size_t)HALF * K * ES;
    const size_t tstep = 2 * hstep;
    const size_t hstepB = Epi::PERM ? (size_t)32 * K * ES : hstep;
    const unsigned ldsw = (unsigned)wid * 1024u;
    const int aoff = lds_byte(wr * 64 + fr, fq * 8), boff = lds_byte(wc * 32 + fr, fq * 8);
#define PG8_SA(b, h) (((b) * 2 + (h)) * HTB)
#define PG8_SB(b, h) ((4 + (b) * 2 + (h)) * HTB)
#define PG8_STAGE(bufoff, gbase, voff) do { _Pragma("unroll") for (int _i = 0; _i < 2; ++_i) \
        __builtin_amdgcn_global_load_lds((const unsigned*)((const char*)(gbase) + (voff)[_i]), (PG8_LAS unsigned*)(lds + (bufoff) + ldsw + _i * 8192), 16, 0, 0); } while (0)
#define PG8_LDA(dst, b, h) do { _Pragma("unroll") for (int m = 0; m < 4; ++m) { const i32x4 lo_ = *(const PG8_LAS i32x4*)(lds + PG8_SA(b, h) + aoff + m * 2048), hi_ = *(const PG8_LAS i32x4*)(lds + PG8_SA(b, h) + aoff + m * 2048 + 1024); dst[m] = __builtin_shufflevector(lo_, hi_, 0, 1, 2, 3, 4, 5, 6, 7); } } while (0)
#define PG8_LDB(dst, b, h) do { _Pragma("unroll") for (int n = 0; n < 2; ++n) { const i32x4 lo_ = *(const PG8_LAS i32x4*)(lds + PG8_SB(b, h) + boff + n * 2048), hi_ = *(const PG8_LAS i32x4*)(lds + PG8_SB(b, h) + boff + n * 2048 + 1024); dst[n] = __builtin_shufflevector(lo_, hi_, 0, 1, 2, 3, 4, 5, 6, 7); } } while (0)
#define PG8_MMA(ai, bj, At, Bt) do { __builtin_amdgcn_s_setprio(1); _Pragma("unroll") for (int m = 0; m < 4; ++m) _Pragma("unroll") for (int n = 0; n < 2; ++n) { \
        if constexpr (FP8) asm volatile("v_mfma_scale_f32_16x16x128_f8f6f4 %0, %1, %2, %0, %3, %3 op_sel_hi:[0,0,0]" : "+v"(acc[ai][bj][m][n]) : "v"(Bt[n]), "v"(At[m]), "v"(scl1));   \
        else { acc[ai][bj][m][n] = __builtin_amdgcn_mfma_f32_16x16x32_bf16(__builtin_bit_cast(bf16x8, __builtin_shufflevector(Bt[n], Bt[n], 0, 1, 2, 3)), __builtin_bit_cast(bf16x8, __builtin_shufflevector(At[m], At[m], 0, 1, 2, 3)), acc[ai][bj][m][n], 0, 0, 0); \
               acc[ai][bj][m][n] = __builtin_amdgcn_mfma_f32_16x16x32_bf16(__builtin_bit_cast(bf16x8, __builtin_shufflevector(Bt[n], Bt[n], 4, 5, 6, 7)), __builtin_bit_cast(bf16x8, __builtin_shufflevector(At[m], At[m], 4, 5, 6, 7)), acc[ai][bj][m][n], 0, 0, 0); } } \
        __builtin_amdgcn_s_setprio(0); } while (0)
#define PG8_WAIT_V(n) asm volatile("s_waitcnt vmcnt(" #n ")" ::: "memory")
#define PG8_WAIT_L(n) asm volatile("s_waitcnt lgkmcnt(" #n ")" ::: "memory")
#define PG8_BAR __builtin_amdgcn_s_barrier()
#define PG8_SCHED __builtin_amdgcn_sched_barrier(0)
    Unit cur, nxt; int ui = 0;
    if (!S.next(0, cur)) return;
    f32x4 acc[2][2][4][2];
#pragma unroll
    for (int a = 0; a < 2; ++a)
#pragma unroll
        for (int b = 0; b < 2; ++b)
#pragma unroll
            for (int m = 0; m < 4; ++m)
#pragma unroll
                for (int n = 0; n < 2; ++n) acc[a][b][m][n] = (f32x4){0.f, 0.f, 0.f, 0.f};
    int scl1 = 0x7f7f7f7f; asm volatile("" : "+v"(scl1));
    i32x8 At[4], B0[2], B1[2];
    const char* cA = (const char*)g.A + (size_t)cur.pm * tstep; const char* cB = (const char*)g.Bt + (size_t)cur.e * g.bstride * ES + (size_t)cur.pn * tstep;
    PG8_STAGE(PG8_SB(0, 0), cB, voffB); PG8_STAGE(PG8_SB(0, 1), cB + hstepB, voffB); PG8_STAGE(PG8_SA(0, 0), cA, voffA); PG8_STAGE(PG8_SA(0, 1), cA + hstep, voffA);
    if (wr == 1) PG8_BAR;
    PG8_WAIT_V(2); PG8_BAR;
    PG8_STAGE(PG8_SB(1, 0), cB + kstep, voffB); PG8_STAGE(PG8_SA(1, 0), cA + kstep, voffA); PG8_STAGE(PG8_SB(1, 1), cB + hstepB + kstep, voffB);
    PG8_WAIT_V(6); PG8_BAR;
    for (;;) {
        const bool has_next = S.next(ui + 1, nxt);
        const char* nA = has_next ? (const char*)g.A + (size_t)nxt.pm * tstep : cA; const char* nB = has_next ? (const char*)g.Bt + (size_t)nxt.e * g.bstride * ES + (size_t)nxt.pn * tstep : cB;
#pragma nounroll
        for (int t = 0; t < nt; t += 2) {
            const bool last = (t == nt - 2);
            const char* a1 = cA + (size_t)(t + 1) * kstep;
            const char* a2 = last ? nA : cA + (size_t)(t + 2) * kstep; const char* b2 = last ? nB : cB + (size_t)(t + 2) * kstep;
            const char* a3 = a2 + kstep; const char* b3 = b2 + kstep;
            PG8_LDB(B0, 0, 0); PG8_LDB(B1, 0, 1); PG8_SCHED; PG8_LDA(At, 0, 0); PG8_STAGE(PG8_SA(1, 1), a1 + hstep, voffA);
            PG8_WAIT_V(8); PG8_WAIT_L(0); PG8_BAR; PG8_MMA(0, 0, At, B0); PG8_MMA(0, 1, At, B1); PG8_BAR; PG8_SCHED;
            PG8_LDA(At, 0, 1); PG8_STAGE(PG8_SB(0, 0), b2, voffB); PG8_STAGE(PG8_SB(0, 1), b2 + hstepB, voffB); PG8_STAGE(PG8_SA(0, 0), a2, voffA);
            PG8_WAIT_V(8); PG8_WAIT_L(0); PG8_BAR; PG8_MMA(1, 0, At, B0); PG8_MMA(1, 1, At, B1); PG8_BAR; PG8_SCHED;
            PG8_LDB(B0, 1, 0); PG8_LDB(B1, 1, 1); PG8_SCHED; PG8_LDA(At, 1, 0); PG8_STAGE(PG8_SA(0, 1), a2 + hstep, voffA);
            PG8_WAIT_V(8); PG8_WAIT_L(0); PG8_BAR; PG8_MMA(0, 0, At, B0); PG8_MMA(0, 1, At, B1); PG8_BAR; PG8_SCHED;
            PG8_LDA(At, 1, 1); PG8_STAGE(PG8_SB(1, 0), b3, voffB); PG8_STAGE(PG8_SB(1, 1), b3 + hstepB, voffB); PG8_STAGE(PG8_SA(1, 0), a3, voffA);
            PG8_WAIT_V(8); PG8_WAIT_L(0); PG8_BAR; PG8_MMA(1, 0, At, B0); PG8_MMA(1, 1, At, B1); PG8_BAR; PG8_SCHED;
        }
        if constexpr (ALIGN_EPI) { if (wr == 0) PG8_BAR; }
        if constexpr (FP8) {
            asm volatile("s_nop 15\n\ts_nop 15" : "+v"(acc[0][0][0][0]), "+v"(acc[0][0][0][1]), "+v"(acc[0][0][1][0]), "+v"(acc[0][0][1][1]), "+v"(acc[0][0][2][0]), "+v"(acc[0][0][2][1]), "+v"(acc[0][0][3][0]), "+v"(acc[0][0][3][1]),
                         "+v"(acc[0][1][0][0]), "+v"(acc[0][1][0][1]), "+v"(acc[0][1][1][0]), "+v"(acc[0][1][1][1]), "+v"(acc[0][1][2][0]), "+v"(acc[0][1][2][1]), "+v"(acc[0][1][3][0]), "+v"(acc[0][1][3][1]));
            asm volatile("s_nop 0" : "+v"(acc[1][0][0][0]), "+v"(acc[1][0][0][1]), "+v"(acc[1][0][1][0]), "+v"(acc[1][0][1][1]), "+v"(acc[1][0][2][0]), "+v"(acc[1][0][2][1]), "+v"(acc[1][0][3][0]), "+v"(acc[1][0][3][1]),
                         "+v"(acc[1][1][0][0]), "+v"(acc[1][1][0][1]), "+v"(acc[1][1][1][0]), "+v"(acc[1][1][1][1]), "+v"(acc[1][1][2][0]), "+v"(acc[1][1][2][1]), "+v"(acc[1][1][3][0]), "+v"(acc[1][1][3][1])); }
        E(acc, cur, wr, wc, fr, fq);
        if (!has_next) break;
#pragma unroll
        for (int a = 0; a < 2; ++a)
#pragma unroll
            for (int b = 0; b < 2; ++b)
#pragma unroll
                for (int m = 0; m < 4; ++m)
#pragma unroll
                    for (int n = 0; n < 2; ++n) acc[a][b][m][n] = (f32x4){0.f, 0.f, 0.f, 0.f};
        cur = nxt; cA = nA; cB = nB; ++ui;
        if constexpr (ALIGN_EPI) { if (wr == 1) PG8_BAR; }
    }
    PG8_WAIT_V(0);
    if constexpr (!ALIGN_EPI) { if (wr == 0) PG8_BAR; }
    PG8_BAR;
#undef PG8_SA
#undef PG8_SB
#undef PG8_STAGE
#undef PG8_LDA
#undef PG8_LDB
#undef PG8_MMA
#undef PG8_WAIT_V
#undef PG8_WAIT_L
#undef PG8_BAR
#undef PG8_SCHED
}
}

constexpr int NWAVES = 8, NTHR = NWAVES * 64;
constexpr int BATCH = 8, SEQ = 4096, D = 1024, NH = 16, HD = 64, DEPTH = 4, NE = 32, TOPK = 4, PLE = 256;
constexpr int T = BATCH * SEQ;
constexpr float LN_EPS = 1e-5f;
constexpr float DN_ALPHA = 1.6817928305074290f;
constexpr float C2 = 0.125f * 1.4426950408889634f;
constexpr int NR_MAX = T * TOPK + NE * 256;
constexpr int NPH = 1 + 12 * DEPTH;
constexpr float Y_SCALE = 16.0f;
constexpr float WGU_SCALE = 64.0f, WD_SCALE = 128.0f, WPG_SCALE = 32.0f;

constexpr size_t MiB = 1u << 20;
constexpr size_t WS_CTL = 0, CTL_ZERO_BYTES = 1 * MiB;
constexpr size_t WS_WIN = 2 * MiB, WIN_STRIDE = 7 * MiB;
constexpr size_t WS_WOUT = 30 * MiB, WS_WR = 38 * MiB, WS_WPP = 40 * MiB, WS_WPG = 42 * MiB;
constexpr size_t WS_WGU = 64 * MiB, WS_WD = 576 * MiB;
constexpr size_t WS_X = 832 * MiB, WS_XB = 960 * MiB, WS_PB = 1024 * MiB, WS_PP = 1088 * MiB;
constexpr size_t WS_PROJ = 1152 * MiB, PROJ_REGION = 64 * MiB;
constexpr size_t WS_H = WS_PROJ;
constexpr size_t WS_Y = 1424 * MiB;
constexpr size_t WS_MISC = 1696 * MiB;
constexpr size_t WS_LOGITS = WS_MISC, WS_TOKE = WS_MISC + 4 * MiB, WS_TOKG = WS_TOKE + MiB / 2, WS_TOKLP = WS_TOKG + MiB / 2, WS_TOKPOS = WS_TOKLP + MiB / 2,
                 WS_ROWGATE = WS_TOKPOS + MiB / 2, WS_WGOFF = WS_ROWGATE + MiB, WS_CUM = WS_WGOFF + MiB, WS_XB2 = WS_CUM + 2 * MiB, WS_XF8 = WS_XB2 + 64 * MiB, WS_END = WS_XF8 + 32 * MiB;
static_assert(WS_H + (size_t)NR_MAX * 1024 * 2 <= WS_Y && WS_Y + (size_t)NR_MAX * 1024 * 2 <= WS_MISC, "ws map");
constexpr int CW_BAR = 4096;
constexpr int CW_CNT = 16384;

constexpr int RING_OFF = 0, RING_BYTES = 131072;
constexpr int LDSCTL_OFF = RING_BYTES, MISC_OFF = LDSCTL_OFF + 320;
constexpr int TEND_OFF = LDSCTL_OFF + 1024;
constexpr int LDS_BYTES = 147456;

#define GAS __attribute__((address_space(1)))
#define LAS __attribute__((address_space(3)))
typedef unsigned short bf16;
typedef unsigned v4u __attribute__((ext_vector_type(4)));
typedef unsigned v2u __attribute__((ext_vector_type(2)));
typedef float f32x4 __attribute__((ext_vector_type(4)));
typedef float f32x16 __attribute__((ext_vector_type(16)));
typedef float f32x2_ __attribute__((ext_vector_type(2)));
typedef short bf16x8 __attribute__((ext_vector_type(8)));
typedef short s16x4 __attribute__((ext_vector_type(4)));
typedef GAS unsigned gu32;
#define RLX_AGENT __ATOMIC_RELAXED, __HIP_MEMORY_SCOPE_AGENT
#define LDS_WAIT() asm volatile("s_waitcnt lgkmcnt(0)" ::: "memory")
#define VM_WAIT() asm volatile("s_waitcnt vmcnt(0)" ::: "memory")
__device__ __forceinline__ unsigned f2bf(float f) { unsigned u = __builtin_bit_cast(unsigned, f); return (u + 0x7fffu + ((u >> 16) & 1u)) >> 16; }
__device__ __forceinline__ unsigned pk2(float lo, float hi) { return f2bf(lo) | (f2bf(hi) << 16); }
__device__ __forceinline__ float bflo(unsigned w) { return __uint_as_float(w << 16); }
__device__ __forceinline__ float bfhi(unsigned w) { return __uint_as_float(w & 0xffff0000u); }

#define XB_TMO      128
#define XB_XCNT(j)  (256  + 64 * (j))
#define XB_XSUB(j)  (1280 + 64 * (j))
#define XB_XGEN(j)  (2304 + 64 * (j))
#define XB_TOP      3328
#define XB_TOPGEN   3392
#define XCD_BAR_WORDS 3456
#define XB_SPIN_CAP (1u << 18)

__device__ __forceinline__ unsigned xb_ld(unsigned* p)              { return __hip_atomic_load(p, __ATOMIC_RELAXED, __HIP_MEMORY_SCOPE_AGENT); }
__device__ __forceinline__ unsigned xb_add(unsigned* p, unsigned v) { return __hip_atomic_fetch_add(p, v, __ATOMIC_RELAXED, __HIP_MEMORY_SCOPE_AGENT); }
__device__ __forceinline__ unsigned xb_xcc_id() { return (unsigned)__builtin_amdgcn_s_getreg((3 << 11) | 20) & 0xFu; }
#define XB_SPIN(cond, bar) do { unsigned _sp = 0; while (cond) { __builtin_amdgcn_s_sleep(1); \
    if ((++_sp & 255u) == 0u) { if (xb_ld(&(bar)[XB_TMO])) break; if (_sp > XB_SPIN_CAP) { atomicAdd(&(bar)[XB_TMO], 1u); break; } } } } while (0)

struct XcdBarrier { unsigned* bar; unsigned x; volatile LAS unsigned* st; int t0; };

__device__ __forceinline__ XcdBarrier xcd_barrier_post(unsigned* bar, volatile LAS unsigned* st, bool is_t0) {
    XcdBarrier b; b.bar = bar; b.x = xb_xcc_id(); b.st = st; b.t0 = 0;
    if (is_t0) (void)xb_add(&bar[XB_XCNT(b.x)], 1u);
    return b;
}
__device__ __forceinline__ void xcd_barrier_complete(unsigned* bar, unsigned x, unsigned& nloc, unsigned& nx) {
    const unsigned G = gridDim.x * gridDim.y * gridDim.z;
    unsigned sum, cnt, mine, sp = 0u;
    for (;;) {
        sum = 0u; cnt = 0u; mine = 0u;
#pragma unroll
        for (unsigned j = 0; j < 16; ++j) { const unsigned c = xb_ld(&bar[XB_XCNT(j)]); sum += c; cnt += (c > 0u) ? 1u : 0u; mine = (j == x) ? c : mine; }
        if (sum == G) break;
        __builtin_amdgcn_s_sleep(1);
        if ((++sp & 255u) == 0u) { if (xb_ld(&bar[XB_TMO])) break; if (sp > XB_SPIN_CAP) { atomicAdd(&bar[XB_TMO], 1u); break; } }
    }
    nloc = mine > 0u ? mine : 1u; nx = cnt > 0u ? cnt : 1u;
}
__device__ __forceinline__ void xcd_barrier(const XcdBarrier& b, bool is_t0) {
    asm volatile("s_waitcnt vmcnt(0)" ::: "memory");
    __syncthreads();
    if (is_t0) {
        unsigned* bar = b.bar;
        __builtin_amdgcn_s_waitcnt(0);
        unsigned nloc = b.st[0], nx = b.st[1];
        if (nloc == 0u) { xcd_barrier_complete(bar, b.x, nloc, nx); b.st[0] = nloc; b.st[1] = nx; }
        const unsigned old = xb_add(&bar[XB_XSUB(b.x)], 1u);
        const unsigned gen = old / nloc;
        if (old + 1u == (gen + 1u) * nloc) {
            __builtin_amdgcn_fence(__ATOMIC_RELEASE, "agent");
            asm volatile("s_waitcnt vmcnt(0)" ::: "memory");
            const unsigned og = xb_add(&bar[XB_TOP], 1u);
            const unsigned tg = og / nx;
            if (og + 1u == (tg + 1u) * nx) xb_add(&bar[XB_TOPGEN], 1u);
            else XB_SPIN(xb_ld(&bar[XB_TOPGEN]) == tg, bar);
            __builtin_amdgcn_fence(__ATOMIC_ACQUIRE, "agent");
            xb_add(&bar[XB_XGEN(b.x)], 1u);
            asm volatile("s_waitcnt vmcnt(0)" ::: "memory");
        } else {
            XB_SPIN(xb_ld(&bar[XB_XGEN(b.x)]) == gen, bar);
            __builtin_amdgcn_fence(__ATOMIC_ACQUIRE, "agent");
            asm volatile("s_waitcnt vmcnt(0)" ::: "memory");
        }
    }
    __syncthreads();
}

struct Args { const float* in[25]; float* out; unsigned char* ws; int ph_lo, ph_hi; };
struct Frame {
    LAS unsigned char* lds;
    gu32* ctl;
    int tid, lane, wave, vcu, G;
    unsigned char* ws;
};

__device__ __forceinline__ float shfl_f(float v, int src_lane) { return __int_as_float(__builtin_amdgcn_ds_bpermute(src_lane << 2, __float_as_int(v))); }
__device__ __forceinline__ int shfl_i(int v, int src_lane) { return __builtin_amdgcn_ds_bpermute(src_lane << 2, v); }
__device__ __forceinline__ float wave_sum(float v, int lane) {
#pragma unroll
    for (int o = 1; o < 64; o <<= 1) v += shfl_f(v, lane ^ o);
    return v;
}
__device__ __forceinline__ void transpose_item(const float* W, int ldw, int K, bf16* WT, int k0, int n0, int drow0, LAS float* scr, int lane) {
    { const int r_ = lane >> 3, q_ = lane & 7; f32x4 v_[8];
#pragma unroll
      for (int i = 0; i < 8; ++i) v_[i] = *(const GAS f32x4*)(W + (size_t)(k0 + 8 * i + r_) * ldw + n0 + 4 * q_);
#pragma unroll
      for (int i = 0; i < 8; ++i) { LAS float* d_ = scr + (8 * i + r_) * 33 + 4 * q_; d_[0] = v_[i].x; d_[1] = v_[i].y; d_[2] = v_[i].z; d_[3] = v_[i].w; } }
    LDS_WAIT(); asm volatile("" ::: "memory");
    const int c = lane & 7;
#pragma unroll
    for (int j = 0; j < 4; ++j) { const int n = (lane >> 3) + 8 * j; const LAS float* s = scr + (8 * c) * 33 + n;
        v4u o; o.x = pk2(s[0 * 33], s[1 * 33]); o.y = pk2(s[2 * 33], s[3 * 33]); o.z = pk2(s[4 * 33], s[5 * 33]); o.w = pk2(s[6 * 33], s[7 * 33]);
        *(GAS v4u*)(WT + (size_t)(drow0 + n) * K + k0 + 8 * c) = o; }
    LDS_WAIT(); asm volatile("" ::: "memory");
}
struct TileRegs { f32x4 v[8]; };
__device__ __forceinline__ void tile_load(TileRegs& t, const float* W, int ldw, int k0, int n0, int lane) {
    const int r_ = lane >> 3, q_ = lane & 7;
#pragma unroll
    for (int i = 0; i < 8; ++i) t.v[i] = *(const GAS f32x4*)(W + (size_t)(k0 + 8 * i + r_) * ldw + n0 + 4 * q_);
}
__device__ __forceinline__ void tile_store8(const TileRegs& t, int K, unsigned char* WT, int k0, int drow0, float scale, LAS float* scr, int lane) {
    { const int r_ = lane >> 3, q_ = lane & 7;
#pragma unroll
      for (int i = 0; i < 8; ++i) { LAS float* d_ = scr + (8 * i + r_) * 33 + 4 * q_; d_[0] = t.v[i].x; d_[1] = t.v[i].y; d_[2] = t.v[i].z; d_[3] = t.v[i].w; } }
    LDS_WAIT(); asm volatile("" ::: "memory");
    const int c = lane & 7;
#pragma unroll
    for (int j = 0; j < 4; ++j) { const int n = (lane >> 3) + 8 * j; const LAS float* s = scr + (8 * c) * 33 + n;
        v2u o; o.x = pg8::pk4_fp8(s[0 * 33] * scale, s[1 * 33] * scale, s[2 * 33] * scale, s[3 * 33] * scale); o.y = pg8::pk4_fp8(s[4 * 33] * scale, s[5 * 33] * scale, s[6 * 33] * scale, s[7 * 33] * scale);
        *(GAS v2u*)(WT + (size_t)(drow0 + n) * K + k0 + 8 * c) = o; }
    LDS_WAIT(); asm volatile("" ::: "memory");
}
__device__ __forceinline__ int in_vrow0(int L) { return 2048; }

__device__ __forceinline__ void p0_prologue(Frame& F, const Args& a) {
    LAS float* scr = (LAS float*)(F.lds + RING_OFF + F.wave * 16384);
    const int gw = F.vcu * NWAVES + F.wave, NGW = F.G * NWAVES;
    unsigned char* ws = F.ws;
    constexpr int IT_MAT = 16 * 32, IT_E = 3 * IT_MAT, IT_L = NE * IT_E, IT_EXP = DEPTH * IT_L;
#define EXP_DECODE(it_, src_, dst_, k0_, n0_, drow_, sc_) do { const int L_ = (it_) / IT_L, r_ = (it_) % IT_L, e_ = r_ / IT_E, r2_ = r_ % IT_E, mat_ = r2_ / IT_MAT, r3_ = r2_ % IT_MAT, kb_ = r3_ / 32, nb_ = r3_ % 32; \
        const size_t moff_ = ((size_t)L_ * NE + e_) * (size_t)(D * D); n0_ = 32 * nb_; k0_ = 64 * kb_; \
        if (mat_ == 2) { src_ = a.in[20] + moff_; dst_ = ws + WS_WD + moff_; drow_ = n0_; sc_ = WD_SCALE; } \
        else { src_ = a.in[mat_ == 0 ? 16 : 18] + moff_; dst_ = ws + WS_WGU + 2 * moff_; drow_ = (n0_ >> 7) * 256 + ((n0_ & 127) >> 5) * 64 + (mat_ == 1 ? 32 : 0);     sc_ = WGU_SCALE; } } while (0)
    { int it = gw; TileRegs cur, nxt; const float* src; unsigned char* dst; int k0, n0, drow; float sc;
      if (it < IT_EXP) { EXP_DECODE(it, src, dst, k0, n0, drow, sc); tile_load(cur, src, D, k0, n0, F.lane); }
      while (it < IT_EXP) {
          const int itn = it + NGW; const float* srcn = src; unsigned char* dstn = dst; int k0n = k0, n0n = n0, drown = drow; float scn = sc;
          if (itn < IT_EXP) { EXP_DECODE(itn, srcn, dstn, k0n, n0n, drown, scn); tile_load(nxt, srcn, D, k0n, n0n, F.lane); }
          tile_store8(cur, D, dst, k0, drow, sc, scr, F.lane);
          cur = nxt; it = itn; src = srcn; dst = dstn; k0 = k0n; n0 = n0n; drow = drown; sc = scn;
      } }
#undef EXP_DECODE
    for (int it = gw; it < DEPTH * 16 * 96; it += NGW) {
        const int L = it / (16 * 96), r = it % (16 * 96), kb = r / 96, nb = r % 96, n0 = 32 * nb;
        const float* src = (L == 0) ? a.in[2] : (L == 1) ? a.in[5] : (L == 2) ? a.in[7] : a.in[2] + (size_t)D * 3 * D;
        const int ldw = (L == 2) ? 3 * D + NH : 3 * D;
        const int drow0 = (L == 0 || L == 3 || n0 < 2048) ? n0 : in_vrow0(L) + n0 - 2048;
        transpose_item(src, ldw, D, (bf16*)(ws + WS_WIN + (size_t)L * WIN_STRIDE), 64 * kb, n0, drow0, scr, F.lane);
    }
    for (int it = gw; it < 2 * DEPTH * IT_MAT; it += NGW) {
        const int w = it / (DEPTH * IT_MAT), r = it % (DEPTH * IT_MAT), L = r / IT_MAT, r3 = r % IT_MAT, kb = r3 / 32, nb = r3 % 32;
        const float* src; bf16* dst;
        if (w == 0) { src = (L == 0) ? a.in[4] : (L == 1) ? a.in[6] : (L == 2) ? a.in[9] : a.in[4] + (size_t)D * D; dst = (bf16*)(ws + WS_WOUT) + (size_t)L * D * D; }
        else { src = a.in[23] + (size_t)L * D * D; dst = (bf16*)(ws + WS_WPG) + (size_t)L * D * D; }
        if (w == 0) transpose_item(src, D, D, dst, 64 * kb, 32 * nb, 32 * nb, scr, F.lane);
        else { TileRegs tr; tile_load(tr, src, D, 64 * kb, 32 * nb, F.lane); tile_store8(tr, D, ws + WS_WPG + (size_t)L * D * D, 64 * kb, 32 * nb, WPG_SCALE, scr, F.lane); }
    }
    for (int it = gw; it < DEPTH * (128 + 16); it += NGW) {
        const int L = it / 144, r = it % 144;
        if (r < 128) transpose_item(a.in[22] + (size_t)L * PLE * D, D, PLE, (bf16*)(ws + WS_WPP) + (size_t)L * D * PLE, 64 * (r / 32), 32 * (r % 32), 32 * (r % 32), scr, F.lane);
        else transpose_item(a.in[14] + (size_t)L * D * NE, NE, D, (bf16*)(ws + WS_WR) + (size_t)L * 256 * D, 64 * (r - 128), 0, 0, scr, F.lane);
    }
    const size_t gt = (size_t)F.vcu * NTHR + F.tid, NGT = (size_t)F.G * NTHR;
    { bf16* win2 = (bf16*)(ws + WS_WIN + 2 * WIN_STRIDE);
      for (size_t i = gt; i < (size_t)NH * D; i += NGT) { const int c = (int)(i / D), k = (int)(i % D); win2[(size_t)(3072 + c) * D + k] = (bf16)f2bf(a.in[7][(size_t)k * (3 * D + NH) + 3 * D + c]); }
      v4u z = {0u, 0u, 0u, 0u};
      for (size_t i = gt; i < (size_t)(256 - NH) * D / 8; i += NGT) *(GAS v4u*)(win2 + (size_t)(3072 + NH) * D + i * 8) = z;
      for (size_t i = gt; i < (size_t)DEPTH * (256 - NE) * D / 8; i += NGT) { const size_t L = i / ((256 - NE) * D / 8), r = i % ((256 - NE) * D / 8);
          *(GAS v4u*)((bf16*)(ws + WS_WR) + L * 256 * D + (size_t)NE * D + r * 8) = z; } }
    { const float* x = a.in[0]; bf16* xb = (bf16*)(ws + WS_XB2);
      for (size_t i = gt; i < (size_t)T * D / 8; i += NGT) { const f32x4 v0 = *(const GAS f32x4*)(x + i * 8), v1 = *(const GAS f32x4*)(x + i * 8 + 4);
          v4u o; o.x = pk2(v0.x, v0.y); o.y = pk2(v0.z, v0.w); o.z = pk2(v1.x, v1.y); o.w = pk2(v1.z, v1.w); *(GAS v4u*)(xb + i * 8) = o; }
      const float* p = a.in[1]; bf16* pb = (bf16*)(ws + WS_PB);
      for (size_t i = gt; i < (size_t)DEPTH * T * PLE / 8; i += NGT) { const f32x4 v0 = *(const GAS f32x4*)(p + i * 8), v1 = *(const GAS f32x4*)(p + i * 8 + 4);
          v4u o; o.x = pk2(v0.x, v0.y); o.y = pk2(v0.z, v0.w); o.z = pk2(v1.x, v1.y); o.w = pk2(v1.z, v1.w); *(GAS v4u*)(pb + i * 8) = o; } }
}

__device__ __forceinline__ void ln_store(f32x4 (&v)[4], float* orow, bf16* obrow, unsigned char* o8row, const float* g, const float* b, int lane) {
    float s = 0.f;
#pragma unroll
    for (int j = 0; j < 4; ++j) s += (v[j].x + v[j].y) + (v[j].z + v[j].w);
    const float mean = wave_sum(s, lane) * (1.f / D); float s2 = 0.f;
#pragma unroll
    for (int j = 0; j < 4; ++j) { v[j] = v[j] - mean; s2 += (v[j].x * v[j].x + v[j].y * v[j].y) + (v[j].z * v[j].z + v[j].w * v[j].w); }
    const float rstd = 1.f / sqrtf(wave_sum(s2, lane) * (1.f / D) + LN_EPS);
#pragma unroll
    for (int j = 0; j < 4; ++j) { const f32x4 gg = *(const GAS f32x4*)(g + 4 * (64 * j + lane)), bb = *(const GAS f32x4*)(b + 4 * (64 * j + lane));
        const f32x4 y = v[j] * rstd * gg + bb;
        if (orow) *(GAS f32x4*)(orow + 4 * (64 * j + lane)) = y;
        v2u o; o.x = pk2(y.x, y.y); o.y = pk2(y.z, y.w); *(GAS v2u*)(obrow + 4 * (64 * j + lane)) = o;
        if (o8row) *(GAS unsigned*)(o8row + 4 * (64 * j + lane)) = pg8::pk4_fp8(y.x, y.y, y.z, y.w); }
}

__device__ __forceinline__ int crow(int r, int hi) { return (r & 3) + 8 * (r >> 2) + 4 * hi; }
__device__ __forceinline__ void sb_task(int b, int h, int qblk, const bf16* Q, const bf16* Kt, const bf16* Vt, bf16* O, int lane) {
    const int r32 = lane & 31, hi = lane >> 5;
    const int q0 = qblk * 32, tq = q0 + r32;
    const size_t rowb = (size_t)b * SEQ;
    bf16x8 qr[4];
    { const bf16* Qp = Q + (rowb + tq) * D + h * HD + hi * 8;
#pragma unroll
      for (int d0 = 0; d0 < 4; ++d0) qr[d0] = *(const GAS bf16x8*)(Qp + d0 * 16); }
    f32x16 o0, o1;
#pragma unroll
    for (int r = 0; r < 16; ++r) { o0[r] = 0.f; o1[r] = 0.f; }
    const bf16* Kb = Kt + (rowb + r32) * D + h * HD + hi * 8;
    const bf16* Vb = Vt + (size_t)(h * HD + r32) * T + rowb + 4 * hi;
    const int jmax = (q0 + 31) >> 6;
    float rrun = 0.f;
    bf16x8 kA[2][4], kB[2][4];
#pragma unroll
    for (int d0 = 0; d0 < 4; ++d0) { kA[0][d0] = *(const GAS bf16x8*)(Kb + (size_t)(64 * jmax) * D + d0 * 16); kA[1][d0] = *(const GAS bf16x8*)(Kb + (size_t)(64 * jmax + 32) * D + d0 * 16); }
    for (int j = jmax; j >= 0; --j) {
        const int s0 = 64 * j;
        if (j > 0) {
#pragma unroll
            for (int d0 = 0; d0 < 4; ++d0) { kB[0][d0] = *(const GAS bf16x8*)(Kb + (size_t)(s0 - 64) * D + d0 * 16); kB[1][d0] = *(const GAS bf16x8*)(Kb + (size_t)(s0 - 32) * D + d0 * 16); }
        }
        f32x16 p0, p1;
#pragma unroll
        for (int r = 0; r < 16; ++r) { p0[r] = 0.f; p1[r] = 0.f; }
#pragma unroll
        for (int d0 = 0; d0 < 4; ++d0) { p0 = __builtin_amdgcn_mfma_f32_32x32x16_bf16(kA[0][d0], qr[d0], p0, 0, 0, 0); p1 = __builtin_amdgcn_mfma_f32_32x32x16_bf16(kA[1][d0], qr[d0], p1, 0, 0, 0); }
        s16x4 va[2][2][2][2];
#pragma unroll
        for (int c = 0; c < 2; ++c)
#pragma unroll
            for (int m = 0; m < 2; ++m) { const bf16* vp = Vb + s0 + 32 * c + 16 * m;
                va[c][m][0][0] = *(const GAS s16x4*)(vp); va[c][m][0][1] = *(const GAS s16x4*)(vp + 8);
                va[c][m][1][0] = *(const GAS s16x4*)(vp + (size_t)32 * T); va[c][m][1][1] = *(const GAS s16x4*)(vp + (size_t)32 * T + 8); }
        const bool diag = (j == jmax);
        f32x16 s0v, s1v; float gt_[8];
#pragma unroll
        for (int r = 0; r < 16; ++r) {
            const float za = fminf(p0[r], 126.f), zb = fminf(p1[r], 126.f);
            float sa = __builtin_amdgcn_logf(1.0f + __builtin_amdgcn_exp2f(za)), sb = __builtin_amdgcn_logf(1.0f + __builtin_amdgcn_exp2f(zb));
            if (diag) { const int kv = s0 + crow(r, hi); if (kv >= tq) sa = 0.f; if (kv + 32 >= tq) sb = 0.f; }
            s0v[r] = sa; s1v[r] = sb;
        }
#pragma unroll
        for (int a4 = 0; a4 < 4; ++a4) {
            s0v[4 * a4 + 2] += s0v[4 * a4 + 3]; s0v[4 * a4 + 1] += s0v[4 * a4 + 2]; s0v[4 * a4] += s0v[4 * a4 + 1]; gt_[a4] = s0v[4 * a4];
            s1v[4 * a4 + 2] += s1v[4 * a4 + 3]; s1v[4 * a4 + 1] += s1v[4 * a4 + 2]; s1v[4 * a4] += s1v[4 * a4 + 1]; gt_[4 + a4] = s1v[4 * a4];
        }
        float run = 0.f; float offs[8];
#pragma unroll
        for (int i = 7; i >= 0; --i) {
            const float other = shfl_f(gt_[i], lane ^ 32);
            const float hi_tot = hi ? gt_[i] : other, lo_tot = hi ? other : gt_[i];
            offs[i] = hi ? run : run + hi_tot;
            run += hi_tot + lo_tot;
        }
#pragma unroll
        for (int r = 0; r < 16; ++r) {
            float w0 = __builtin_amdgcn_exp2f(p0[r] - s0v[r] - offs[r >> 2] + rrun), w1 = __builtin_amdgcn_exp2f(p1[r] - s1v[r] - offs[4 + (r >> 2)] + rrun);
            if (diag) { const int kv = s0 + crow(r, hi); if (kv >= tq) w0 = 0.f; if (kv + 32 >= tq) w1 = 0.f; }
            p0[r] = w0; p1[r] = w1;
        }
        rrun -= run;
#pragma unroll
        for (int c = 0; c < 2; ++c)
#pragma unroll
            for (int m = 0; m < 2; ++m) {
                v4u pw;
                if (c == 0) { pw.x = pg8::cvt_pk_bf16(p0[8 * m], p0[8 * m + 1]); pw.y = pg8::cvt_pk_bf16(p0[8 * m + 2], p0[8 * m + 3]); pw.z = pg8::cvt_pk_bf16(p0[8 * m + 4], p0[8 * m + 5]); pw.w = pg8::cvt_pk_bf16(p0[8 * m + 6], p0[8 * m + 7]); }
                else { pw.x = pg8::cvt_pk_bf16(p1[8 * m], p1[8 * m + 1]); pw.y = pg8::cvt_pk_bf16(p1[8 * m + 2], p1[8 * m + 3]); pw.z = pg8::cvt_pk_bf16(p1[8 * m + 4], p1[8 * m + 5]); pw.w = pg8::cvt_pk_bf16(p1[8 * m + 6], p1[8 * m + 7]); }
                const bf16x8 pf = __builtin_bit_cast(bf16x8, pw);
                const s16x4 a0 = va[c][m][0][0], a1 = va[c][m][0][1], b0 = va[c][m][1][0], b1 = va[c][m][1][1];
                const bf16x8 vf0 = (bf16x8){a0[0], a0[1], a0[2], a0[3], a1[0], a1[1], a1[2], a1[3]}, vf1 = (bf16x8){b0[0], b0[1], b0[2], b0[3], b1[0], b1[1], b1[2], b1[3]};
                o0 = __builtin_amdgcn_mfma_f32_32x32x16_bf16(vf0, pf, o0, 0, 0, 0);
                o1 = __builtin_amdgcn_mfma_f32_32x32x16_bf16(vf1, pf, o1, 0, 0, 0);
            }
        if (__all(rrun < -200.f)) break;
#pragma unroll
        for (int c = 0; c < 2; ++c)
#pragma unroll
            for (int d0 = 0; d0 < 4; ++d0) kA[c][d0] = kB[c][d0];
    }
    bf16* Op = O + (rowb + tq) * D + h * HD + 4 * hi;
#pragma unroll
    for (int a4 = 0; a4 < 4; ++a4) {
        v2u w0, w1;
        w0.x = pg8::cvt_pk_bf16(o0[4 * a4], o0[4 * a4 + 1]); w0.y = pg8::cvt_pk_bf16(o0[4 * a4 + 2], o0[4 * a4 + 3]);
        w1.x = pg8::cvt_pk_bf16(o1[4 * a4], o1[4 * a4 + 1]); w1.y = pg8::cvt_pk_bf16(o1[4 * a4 + 2], o1[4 * a4 + 3]);
        *(GAS v2u*)(Op + 8 * a4) = w0; *(GAS v2u*)(Op + 32 + 8 * a4) = w1;
    }
}
__device__ __forceinline__ void sb_phase(Frame& F, const bf16* Q, const bf16* Kt, const bf16* Vt, bf16* O) {
    const int gw = F.vcu * NWAVES + F.wave, NGW = F.G * NWAVES;
    for (int vw = gw; vw < BATCH * NH * 16; vw += NGW) {
        const int bh = vw >> 4, w16 = vw & 15;
        for (int i = 0; i < 8; ++i) { const int qblk = (i & 1) ? 16 * i + 15 - w16 : 16 * i + w16; sb_task(bh / NH, bh % NH, qblk, Q, Kt, Vt, O, F.lane); }
    }
}

namespace attn_body {
using bf16=unsigned short;
using f32x4=__attribute__((ext_vector_type(4)))float;
using bf16x8=__attribute__((ext_vector_type(8)))short;
using s16x4=__attribute__((ext_vector_type(4)))short;
using f32x16=__attribute__((ext_vector_type(16)))float;
using u32x4=__attribute__((ext_vector_type(4)))unsigned;
constexpr int BATCH=8,NHEAD=16,SEQ=4096,D=64,DM=NHEAD*D;
constexpr int NW=8,QBLK=32,QB=QBLK*NW,KVBLK=64,NQB=SEQ/QB;
constexpr int ATTN_PITCH=DM, ATTN_UNIT_ROWS=QB;
__device__ __forceinline__ int crow(int r,int hi){return (r&3)+8*(r>>2)+4*hi;}
#define SBAR() __builtin_amdgcn_sched_barrier(0)
__device__ __forceinline__ void cmask(f32x16&p0,f32x16&p1,int jb,int qrel,int hi){
  const float NEG=-INFINITY; int kb=64*jb+4*hi;
  #pragma unroll
  for(int r=0;r<16;++r){int kv=kb+(r&3)+8*(r>>2); if(kv>qrel)p0[r]=NEG; if(kv+32>qrel)p1[r]=NEG;}
}

constexpr int NSLOT=3, SLOTB=8192;
constexpr int LDS_K=0, LDS_V=NSLOT*SLOTB, LDS_WS=2*NSLOT*SLOTB, LDS_OST=LDS_WS+NW*64*4, LDS_NB=LDS_OST+NW*4096+2048, LDS_BYTES=LDS_NB+SEQ*4;
constexpr float C2=0.125f*1.4426950408889634f;
__device__ __forceinline__ void glds16(const void*gsrc,unsigned lds_dst){unsigned keep;
  asm volatile("s_mov_b32 %0, m0\n\ts_mov_b32 m0, %2\n\ts_nop 0\n\tglobal_load_lds_dwordx4 %1, off\n\ts_mov_b32 m0, %0":"=&s"(keep):"v"(gsrc),"s"(lds_dst):"memory");}
__device__ __forceinline__ float max3f(float a,float b,float c){float r;asm("v_max3_f32 %0, %1, %2, %3":"=v"(r):"v"(a),"v"(b),"v"(c));return r;}
__device__ __forceinline__ float max2f(float a,float b){float r;asm("v_max_f32_e32 %0, %1, %2":"=v"(r):"v"(a),"v"(b));return r;}
__device__ __forceinline__ float fadd_s(float a,float b){float r;asm("v_add_f32_e32 %0, %1, %2":"=v"(r):"v"(a),"v"(b));return r;}
__device__ __forceinline__ float fsub_s(float a,float b){float r;asm("v_sub_f32_e32 %0, %1, %2":"=v"(r):"v"(a),"v"(b));return r;}
typedef float f32x2_t __attribute__((ext_vector_type(2))); typedef __bf16 bf16x2_t __attribute__((ext_vector_type(2)));
__device__ __forceinline__ unsigned cvtpk_s(float lo,float hi){f32x2_t v={lo,hi};bf16x2_t b=__builtin_convertvector(v,bf16x2_t);return __builtin_bit_cast(unsigned,b);}
#define WAIT_BAR(N) asm volatile("s_waitcnt vmcnt(" #N ") lgkmcnt(0)\n\ts_barrier":::"memory")

__device__ __forceinline__ void qkt(f32x16&p0,f32x16&p1,const char*Kslot,const bf16x8*qr,const f32x16&c0i,const f32x16&c1i,int r32,int hi){
  const char*kb=Kslot+hi*1024+r32*16;
  #pragma unroll
  for(int d0=0;d0<4;++d0){
    const bf16x8 b0=*reinterpret_cast<const bf16x8*>(kb+d0*2048);
    const bf16x8 b1=*reinterpret_cast<const bf16x8*>(kb+d0*2048+512);
    if(d0==0){p0=__builtin_amdgcn_mfma_f32_32x32x16_bf16(b0,qr[0],c0i,0,0,0);p1=__builtin_amdgcn_mfma_f32_32x32x16_bf16(b1,qr[0],c1i,0,0,0);}
    else{p0=__builtin_amdgcn_mfma_f32_32x32x16_bf16(b0,qr[d0],p0,0,0,0);p1=__builtin_amdgcn_mfma_f32_32x32x16_bf16(b1,qr[d0],p1,0,0,0);}}
}
typedef __attribute__((address_space(3))) const char* lds_cptr;
typedef short v4i16_t __attribute__((ext_vector_type(4)));
__device__ __forceinline__ void kload8(bf16x8*kf,lds_cptr kp){
  kf[0]=*(const __attribute__((address_space(3))) bf16x8*)(kp);      kf[1]=*(const __attribute__((address_space(3))) bf16x8*)(kp+512);
  kf[2]=*(const __attribute__((address_space(3))) bf16x8*)(kp+2048); kf[3]=*(const __attribute__((address_space(3))) bf16x8*)(kp+2560);
  kf[4]=*(const __attribute__((address_space(3))) bf16x8*)(kp+4096); kf[5]=*(const __attribute__((address_space(3))) bf16x8*)(kp+4608);
  kf[6]=*(const __attribute__((address_space(3))) bf16x8*)(kp+6144); kf[7]=*(const __attribute__((address_space(3))) bf16x8*)(kp+6656);
}
__device__ __forceinline__ void kload2(bf16x8*kf,lds_cptr kp,int j){ kf[2*j]=*(const __attribute__((address_space(3))) bf16x8*)(kp+j*2048); kf[2*j+1]=*(const __attribute__((address_space(3))) bf16x8*)(kp+j*2048+512); }
__device__ __forceinline__ s16x4 vtr(lds_cptr p){ return __builtin_bit_cast(s16x4,__builtin_amdgcn_ds_read_tr16_b64_v4i16((__attribute__((address_space(3))) v4i16_t*)p)); }
__device__ __forceinline__ float rowmax(const f32x16&p0,const f32x16&p1){
  float a=max3f(p0[0],p0[1],p1[0]),b=max3f(p0[2],p0[3],p1[1]);a=max3f(a,p1[2],p1[3]);
  #pragma unroll
  for(int r=4;r<16;r+=4){a=max3f(a,p0[r],p0[r+1]);b=max3f(b,p0[r+2],p0[r+3]);a=max3f(a,p1[r],p1[r+1]);b=max3f(b,p1[r+2],p1[r+3]);}
  const float m=max2f(a,b);
  auto rr=__builtin_amdgcn_permlane32_swap(__float_as_uint(m),__float_as_uint(m),false,false);
  return max2f(__uint_as_float(rr[0]),__uint_as_float(rr[1]));
}
__device__ __forceinline__ void pv(f32x16*o,int vb,bf16x8 pa0,bf16x8 pa1,bf16x8 pa2,bf16x8 pa3){
  #pragma unroll
  for(int d0=0;d0<2;++d0){s16x4 lo[4],hi[4];
    #pragma unroll
    for(int ks=0;ks<4;++ks){
      asm volatile("ds_read_b64_tr_b16 %0,%1 offset:%c2":"=&v"(lo[ks]):"v"(vb),"i"(d0*4096+ks*1024):"memory");
      asm volatile("ds_read_b64_tr_b16 %0,%1 offset:%c2":"=&v"(hi[ks]):"v"(vb),"i"(d0*4096+ks*1024+512):"memory");}
    asm volatile("s_waitcnt lgkmcnt(0)":::"memory");SBAR();
    #define PK(k) (bf16x8){lo[k][0],lo[k][1],lo[k][2],lo[k][3],hi[k][0],hi[k][1],hi[k][2],hi[k][3]}
    o[d0]=__builtin_amdgcn_mfma_f32_32x32x16_bf16(pa0,PK(0),o[d0],0,0,0);
    o[d0]=__builtin_amdgcn_mfma_f32_32x32x16_bf16(pa1,PK(1),o[d0],0,0,0);
    o[d0]=__builtin_amdgcn_mfma_f32_32x32x16_bf16(pa2,PK(2),o[d0],0,0,0);
    o[d0]=__builtin_amdgcn_mfma_f32_32x32x16_bf16(pa3,PK(3),o[d0],0,0,0);
    #undef PK
  }
}

#ifndef ATTN_STORE16
#define ATTN_STORE16(p,v) (*(u32x4*)(p)=(v))
#endif
template<int THRL> __device__ __forceinline__ void attn_unit(int b,int h,int qb,const bf16*Q,const bf16*__restrict__ K,const bf16*__restrict__ V,bf16*O,char*shm,const int tid,const int t0){
  const int lane=tid&63,r32=lane&31,hi=lane>>5; const int wid=__builtin_amdgcn_readfirstlane(tid>>6);
  const long rowbase=(long)b*SEQ; const int q0=qb*QB;
  const bf16*Qw=Q+(rowbase+q0+wid*QBLK)*DM+h*D;
  const bf16*Kh=K+(rowbase+(long)t0*KVBLK)*DM+h*D,*Vh=V+(rowbase+(long)t0*KVBLK)*DM+h*D;
  const unsigned lds0=(unsigned)(uintptr_t)shm;
  float*wsf=(float*)(shm+LDS_WS)+wid*64;
  const bf16*ksrc=Kh+(long)lane*DM+wid*8;
  const bf16*vsrc=Vh+(long)(16*(wid&3)+(lane>>2))*DM+(wid>>2)*32+(lane&3)*8;
  const unsigned kdst=lds0+LDS_K+wid*1024, vdst=lds0+LDS_V+wid*1024;
  #define DMA_K(t,slot) glds16(ksrc+(long)(t)*KVBLK*DM,(unsigned)__builtin_amdgcn_readfirstlane(kdst+(slot)))
  #define DMA_V(t,slot) glds16(vsrc+(long)(t)*KVBLK*DM,(unsigned)__builtin_amdgcn_readfirstlane(vdst+(slot)))
  const int vb0=(int)(lds0+LDS_V)+((lane>>4)&1)*32+(lane&3)*8+(4*hi+((lane&15)>>2))*64;
  const char*Kbase=shm+LDS_K; bf16x8 kf[8];
  const lds_cptr shm3=(lds_cptr)shm; const lds_cptr kp0=shm3+LDS_K+hi*1024+r32*16; const lds_cptr vp0=shm3+LDS_V+((lane>>4)&1)*32+(lane&3)*8+(4*hi+((lane&15)>>2))*64;
  const int NT=(q0+QB)/KVBLK-t0;
  DMA_K(0,0);DMA_V(0,0);DMA_K(1,SLOTB);
  bf16x8 qr[4];
  #pragma unroll
  for(int d0=0;d0<4;++d0)qr[d0]=*reinterpret_cast<const bf16x8*>(&Qw[(long)r32*DM+d0*16+hi*8]);
  float mhat=0.f,l_reg=0.f;f32x16 o[2];o[0]=f32x16{};o[1]=f32x16{};float nmh=0.f;
  const int qrel=wid*QBLK+r32;
  const __attribute__((address_space(3))) float* nbt=(const __attribute__((address_space(3))) float*)(shm3+LDS_NB)+64*t0;
  #define MKCB(C0,C1,t) do{ const __attribute__((address_space(3))) float* bp_=nbt+64*(t)+4*hi; _Pragma("unroll") for(int a_=0;a_<4;++a_){ const f32x4 v0_=*(const __attribute__((address_space(3))) f32x4*)(bp_+8*a_), v1_=*(const __attribute__((address_space(3))) f32x4*)(bp_+32+8*a_); _Pragma("unroll") for(int i_=0;i_<4;++i_){ C0[4*a_+i_]=v0_[i_]+nmh; C1[4*a_+i_]=v1_[i_]+nmh; } } }while(0)
  #define CMASK(P0,P1,t) do{int jb_=(t)-(NT-4); if(jb_>=0)cmask(P0,P1,jb_,qrel,hi);}while(0)
  bool resc=false;
  #define START(P0,P1) do{ const float rm=rowmax(P0,P1); resc=false; \
    { const float dl=rm; mhat=fadd_s(mhat,dl); \
      _Pragma("unroll") for(int r=0;r<16;++r){P0[r]=fsub_s(P0[r],dl);P1[r]=fsub_s(P1[r],dl);} \
      nmh=-mhat; } \
    _Pragma("unroll") for(int r=0;r<16;++r)P0[r]=__builtin_amdgcn_exp2f(P0[r]); }while(0)
  #define RESC() do{ if(resc){ asm volatile("s_waitcnt lgkmcnt(0)":::"memory"); \
      _Pragma("unroll") for(int d_=0;d_<2;++d_) _Pragma("unroll") for(int r=0;r<16;++r)o[d_][r]*=wsf[crow(r,hi)]; } }while(0)
  f32x16 pA0,pA1,pB0,pB1;
  int sl_prev=0,sl_cur=0,sl_next=SLOTB;
  #define ROT() do{sl_prev=sl_cur;sl_cur=sl_next;sl_next=(sl_next==(NSLOT-1)*SLOTB)?0:sl_next+SLOTB;}while(0)
  DMA_K(2,2*SLOTB);
  WAIT_BAR(3);
  MKCB(pA0,pA1,0); qkt(pA0,pA1,Kbase,qr,pA0,pA1,r32,hi);asm volatile("s_nop 15\n\ts_nop 7":"+v"(pA0),"+v"(pA1));CMASK(pA0,pA1,0);
  START(pA0,pA1);
  _Pragma("unroll") for(int r=0;r<16;++r)pA1[r]=__builtin_amdgcn_exp2f(pA1[r]);
  WAIT_BAR(0);
  DMA_K(3,0);DMA_V(1,SLOTB);
  ROT();
  kload8(kf,kp0+sl_cur);
  WAIT_BAR(2);
  s16x4 vlo[8],vhi[8]; u32x4 pw0,pw1,pw2,pw3;
  #define PKW(P,B) cvtpk_s(P[B],P[B+1])
  #define PAF(k) __builtin_bit_cast(bf16x8,pw##k)
  #define VFR(i) (bf16x8){vlo[i][0],vlo[i][1],vlo[i][2],vlo[i][3],vhi[i][0],vhi[i][1],vhi[i][2],vhi[i][3]}
  #define PIN(x) asm volatile("":"+v"(x))
  #define MX3(a,b,c) __builtin_fmaxf(__builtin_fmaxf((a),(b)),(c))
  #define GAPA(MF,A0,A1,A2,A3,W0,W1,PW) do{ MF; sacc+=A0; sacc+=A1; sacc+=A2; sacc+=A3; PIN(sacc); W0; W1; PIN(PW); SBAR(); }while(0)
  #define EX(v) __builtin_amdgcn_exp2f(v)
  #define GAPB(MF,X,B) do{ MF; X[B]=EX(X[B]); X[B+1]=EX(X[B+1]); X[B+2]=EX(X[B+2]); X[B+3]=EX(X[B+3]); PIN(X); SBAR(); }while(0)
  #define VRD(i) do{ vlo[i]=vtr(vp_+(((i)>>2)*4096+((i)&3)*1024)); vhi[i]=vtr(vp_+(((i)>>2)*4096+((i)&3)*1024+512)); }while(0)
  #define KRD(G,j) do{ if(G){ kload2(kf,kp0+sl_next,j); SBAR(); } }while(0)
  #define STEP(C0,C1,P0,P1,t,GK,GV,GL) do{ SBAR(); MKCB(C0,C1,t); SBAR(); \
    const lds_cptr vp_=vp0+sl_prev; \
    VRD(0); SBAR(); float sacc=(P0[0]+P0[1]); \
    GAPA(C0=__builtin_amdgcn_mfma_f32_32x32x16_bf16(kf[0],qr[0],C0,0,0,0), P0[2],P0[3],P0[4],P0[5],     pw0[0]=PKW(P0,0), pw0[1]=PKW(P0,2), pw0); \
    VRD(4); SBAR(); GAPA(C1=__builtin_amdgcn_mfma_f32_32x32x16_bf16(kf[1],qr[0],C1,0,0,0), P0[6],P0[7],P0[8],P0[9],     pw0[2]=PKW(P0,4), pw0[3]=PKW(P0,6), pw0); \
    VRD(1); SBAR(); GAPA(C0=__builtin_amdgcn_mfma_f32_32x32x16_bf16(kf[2],qr[1],C0,0,0,0),   P0[10],P0[11],P0[12],P0[13], pw1[0]=PKW(P0,8), pw1[1]=PKW(P0,10), pw1); \
    VRD(5); SBAR(); GAPA(C1=__builtin_amdgcn_mfma_f32_32x32x16_bf16(kf[3],qr[1],C1,0,0,0),   P0[14],P0[15],P1[0],P1[1],   pw1[2]=PKW(P0,12),pw1[3]=PKW(P0,14), pw1); \
    VRD(2); SBAR(); GAPA(C0=__builtin_amdgcn_mfma_f32_32x32x16_bf16(kf[4],qr[2],C0,0,0,0),   P1[2],P1[3],P1[4],P1[5],     pw2[0]=PKW(P1,0), pw2[1]=PKW(P1,2), pw2); \
    VRD(6); SBAR(); GAPA(C1=__builtin_amdgcn_mfma_f32_32x32x16_bf16(kf[5],qr[2],C1,0,0,0),   P1[6],P1[7],P1[8],P1[9],     pw2[2]=PKW(P1,4), pw2[3]=PKW(P1,6), pw2); \
    VRD(3); SBAR(); GAPA(C0=__builtin_amdgcn_mfma_f32_32x32x16_bf16(kf[6],qr[3],C0,0,0,0),   P1[10],P1[11],P1[12],P1[13], pw3[0]=PKW(P1,8), pw3[1]=PKW(P1,10), pw3); \
    VRD(7); SBAR(); GAPA(C1=__builtin_amdgcn_mfma_f32_32x32x16_bf16(kf[7],qr[3],C1,0,0,0),   P1[14],P1[15],0.f,0.f,       pw3[2]=PKW(P1,12),pw3[3]=PKW(P1,14), pw3); \
    l_reg+=sacc; \
    if(GK){DMA_K((t)+3,sl_cur);} if(GV){DMA_V((t)+1,sl_next);} \
    CMASK(C0,C1,t); \
    { float a=MX3(C0[0],C0[1],C1[0]),b=MX3(C0[2],C0[3],C1[1]); a=MX3(a,C1[2],C1[3]); \
      _Pragma("unroll") for(int r=4;r<16;r+=4){a=MX3(a,C0[r],C0[r+1]);b=MX3(b,C0[r+2],C0[r+3]);a=MX3(a,C1[r],C1[r+1]);b=MX3(b,C1[r+2],C1[r+3]);} \
      float rm=__builtin_fmaxf(a,b); { auto rr=__builtin_amdgcn_permlane32_swap(__float_as_uint(rm),__float_as_uint(rm),false,false); rm=__builtin_fmaxf(__uint_as_float(rr[0]),__uint_as_float(rr[1])); } \
      resc=false; \
      if(__builtin_expect(__any(rm>(float)THRL),0)){ const float dl=__builtin_fmaxf(rm,0.f); mhat+=dl; \
        _Pragma("unroll") for(int r=0;r<16;++r){C0[r]-=dl;C1[r]-=dl;} \
        nmh=-mhat; \
        const float f=__builtin_amdgcn_exp2f(-dl); l_reg*=f; if(hi==0)wsf[r32]=f; resc=true; } } \
    SBAR(); \
    GAPB(o[0]=__builtin_amdgcn_mfma_f32_32x32x16_bf16(PAF(0),VFR(0),o[0],0,0,0), C0,0); \
    GAPB(o[1]=__builtin_amdgcn_mfma_f32_32x32x16_bf16(PAF(0),VFR(4),o[1],0,0,0), C0,4); \
    KRD(GL,0); GAPB(o[0]=__builtin_amdgcn_mfma_f32_32x32x16_bf16(PAF(1),VFR(1),o[0],0,0,0), C0,8); \
    KRD(GL,1); GAPB(o[1]=__builtin_amdgcn_mfma_f32_32x32x16_bf16(PAF(1),VFR(5),o[1],0,0,0), C0,12); \
    KRD(GL,2); GAPB(o[0]=__builtin_amdgcn_mfma_f32_32x32x16_bf16(PAF(2),VFR(2),o[0],0,0,0), C1,0); \
    KRD(GL,3); GAPB(o[1]=__builtin_amdgcn_mfma_f32_32x32x16_bf16(PAF(2),VFR(6),o[1],0,0,0), C1,4); \
    GAPB(o[0]=__builtin_amdgcn_mfma_f32_32x32x16_bf16(PAF(3),VFR(3),o[0],0,0,0), C1,8); \
    GAPB(o[1]=__builtin_amdgcn_mfma_f32_32x32x16_bf16(PAF(3),VFR(7),o[1],0,0,0), C1,12); \
    }while(0)
  int t=1;
  #undef CMASK
  #define CMASK(P0,P1,t) do{}while(0)
  for(;t+5<NT;t+=2){
    STEP(pB0,pB1,pA0,pA1,t,true,true,true);     WAIT_BAR(2); RESC(); ROT();
    STEP(pA0,pA1,pB0,pB1,t+1,true,true,true);   WAIT_BAR(2); RESC(); ROT();
  }
  #undef CMASK
  #define CMASK(P0,P1,t) do{int jb_=(t)-(NT-4); if(jb_>=0)cmask(P0,P1,jb_,qrel,hi);}while(0)
  #define ENDW(tt) do{ if((tt)+3<NT){WAIT_BAR(2);} else if((tt)+2<NT){WAIT_BAR(1);} else {WAIT_BAR(0);} }while(0)
  for(;t+1<NT;t+=2){
    STEP(pB0,pB1,pA0,pA1,t,(t+3<NT),(t+1<NT),(t+1<NT));       ENDW(t);   RESC(); ROT();
    STEP(pA0,pA1,pB0,pB1,t+1,(t+4<NT),(t+2<NT),(t+2<NT));     ENDW(t+1); RESC(); ROT();
  }
  STEP(pB0,pB1,pA0,pA1,NT-1,false,false,false); RESC();
  { float sacc=pB0[0]+pB0[1]; _Pragma("unroll") for(int r=2;r<16;++r)sacc+=pB0[r]; _Pragma("unroll") for(int r=0;r<16;++r)sacc+=pB1[r]; l_reg+=sacc;
    pw0=(u32x4){PKW(pB0,0),PKW(pB0,2),PKW(pB0,4),PKW(pB0,6)};pw1=(u32x4){PKW(pB0,8),PKW(pB0,10),PKW(pB0,12),PKW(pB0,14)};pw2=(u32x4){PKW(pB1,0),PKW(pB1,2),PKW(pB1,4),PKW(pB1,6)};pw3=(u32x4){PKW(pB1,8),PKW(pB1,10),PKW(pB1,12),PKW(pB1,14)};
    SBAR(); pv(o,vb0+sl_cur,PAF(0),PAF(1),PAF(2),PAF(3)); }
  #undef PKW
  #undef PAF
  #undef VFR
  #undef PIN
  #undef MX3
  #undef GAPA
  #undef GAPB
  #undef EX
  #undef VRD
  #undef KRD
  #undef STEP
  #undef ENDW
  {auto rr=__builtin_amdgcn_permlane32_swap(__float_as_uint(l_reg),__float_as_uint(l_reg),false,false);l_reg=__uint_as_float(rr[0])+__uint_as_float(rr[1]);}
  if(hi==0)wsf[32+r32]=l_reg;asm volatile("s_waitcnt lgkmcnt(0)":::"memory");
  float rli[16];
  #pragma unroll
  for(int r=0;r<16;++r)rli[r]=__builtin_amdgcn_rcpf(wsf[32+crow(r,hi)]);
  bf16*Ow=O+(rowbase+q0+wid*QBLK)*DM+h*D;
  { bf16*stg=(bf16*)(shm+LDS_OST)+wid*2048;
    #pragma unroll
    for(int r=0;r<16;++r){const int orow=crow(r,hi);
      #pragma unroll
      for(int d0=0;d0<2;++d0)stg[orow*64+d0*32+r32]=(bf16)(cvtpk_s(o[d0][r]*rli[r],0.f)&0xffffu);}
    asm volatile("s_waitcnt lgkmcnt(0)":::"memory");
    #pragma unroll
    for(int i=0;i<4;++i){const int row=i*8+(lane>>3),ch=lane&7; const u32x4 v=*(const u32x4*)(stg+row*64+ch*8); ATTN_STORE16(Ow+(long)row*DM+ch*8,v);} }
  asm volatile("s_waitcnt lgkmcnt(0)\n\ts_barrier":::"memory");
  #undef MKCB
  #undef DMA_K
  #undef DMA_V
  #undef CMASK
  #undef START
  #undef RESC
  #undef ROT
}
constexpr int ATTN_LDS_BYTES=LDS_BYTES;
struct AttnTensors { const bf16* Q; const bf16* K; const bf16* V; bf16* O; };
struct AttnUnit { int bh; int qb; };
struct FoxOrder {
  int vcu,G;
  __device__ __forceinline__ bool next(int i,AttnUnit&u)const{ const int v=vcu+(i>>3)*G; if(v>=BATCH*NHEAD*2)return false; const int ii=i&7,p=v&1; u.bh=v>>1; u.qb=(ii&1)?16-ii-p:ii+p; return true; }
};
template<int THRL=8> __device__ __forceinline__ void fox_phase(char*lds,const AttnTensors&T,const bf16*gate,const float*bfp,const FoxOrder&S,const int wave_){
  for(int v=S.vcu;v<BATCH*NHEAD*2;v+=S.G){
    int tid_=tid_of(wave_); asm volatile("":"+v"(tid_));
    const int lane_=tid_&63, wid_=__builtin_amdgcn_readfirstlane(tid_>>6);
    const int bh=v>>1, b_=bh/NHEAD, h_=bh%NHEAD; float thr;
    { const float bf_=bfp[h_];
      __attribute__((address_space(3))) float* nb=(__attribute__((address_space(3))) float*)((__attribute__((address_space(3))) char*)lds+LDS_NB);
      __attribute__((address_space(3))) float* wt=(__attribute__((address_space(3))) float*)((__attribute__((address_space(3))) char*)lds+LDS_WS);
      const bf16* gp=gate+((size_t)b_*SEQ+8*tid_)*DM+h_;
      float p[8]; float run=0.f;
      _Pragma("unroll") for(int k=0;k<8;++k){ const float z2=(__uint_as_float((unsigned)gp[(size_t)k*DM]<<16)+bf_)*1.4426950408889634f;
        run+=fminf(z2,0.f)-__builtin_amdgcn_logf(1.0f+__builtin_amdgcn_exp2f(-fabsf(z2))); p[k]=run; }
      float inc=run;
      _Pragma("unroll") for(int o=1;o<64;o<<=1){ const float vv=__int_as_float(__builtin_amdgcn_ds_bpermute((lane_-o)<<2,__float_as_int(inc))); if(lane_>=o)inc+=vv; }
      float mq=0.f,mk=0.f;
      for(int k=0;k<8;++k){ const bf16* kp=T.K+((size_t)b_*SEQ+8*tid_+k)*DM+h_*D; const bf16* qp=T.Q+((size_t)b_*SEQ+8*tid_+k)*DM+h_*D; float sq=0.f,sk=0.f;
        _Pragma("unroll") for(int c=0;c<8;++c){ const u32x4 a=*(const u32x4*)(kp+8*c), q=*(const u32x4*)(qp+8*c);
          _Pragma("unroll") for(int e=0;e<4;++e){ const float al=__uint_as_float(a[e]<<16),ah=__uint_as_float(a[e]&0xffff0000u),ql=__uint_as_float(q[e]<<16),qh=__uint_as_float(q[e]&0xffff0000u); sk+=al*al+ah*ah; sq+=ql*ql+qh*qh; } }
        mq=fmaxf(mq,sq); mk=fmaxf(mk,sk); }
      _Pragma("unroll") for(int o=1;o<64;o<<=1){ mq=fmaxf(mq,__int_as_float(__builtin_amdgcn_ds_bpermute((lane_^o)<<2,__float_as_int(mq)))); mk=fmaxf(mk,__int_as_float(__builtin_amdgcn_ds_bpermute((lane_^o)<<2,__float_as_int(mk)))); }
      if(lane_==63) wt[wid_]=inc;
      if(lane_==0){ wt[16+wid_]=mq; wt[24+wid_]=mk; }
      asm volatile("s_waitcnt lgkmcnt(0)\n\ts_barrier":::"memory");
      float base=inc-run;
      _Pragma("unroll") for(int w=0;w<7;++w) if(w<wid_) base+=wt[w];
      _Pragma("unroll") for(int k=0;k<8;++k) nb[8*tid_+k]=-(base+p[k]);
      float aq=0.f,ak=0.f; _Pragma("unroll") for(int w=0;w<8;++w){ aq=fmaxf(aq,wt[16+w]); ak=fmaxf(ak,wt[24+w]); }
      thr=__int_as_float(__builtin_amdgcn_readfirstlane(__float_as_int(152.0f+2.0f*(sqrtf(aq)*sqrtf(ak)*1.01f+0.5f))));
      asm volatile("s_waitcnt vmcnt(0) lgkmcnt(0)\n\ts_barrier":::"memory"); }
    for(int ii=0;ii<8;++ii){
      const int p_=v&1, qb=(ii&1)?16-ii-p_:ii+p_;
      int t0=0;
      { const __attribute__((address_space(3))) float* nb=(const __attribute__((address_space(3))) float*)((const __attribute__((address_space(3))) char*)lds+LDS_NB);
        const float nq=nb[qb*QB]; const int tmax=4*qb;
        while(t0+2<=tmax && nq-nb[64*(t0+2)-1]>thr) t0+=2;
        t0=__builtin_amdgcn_readfirstlane(t0); }
      attn_unit<THRL>(b_,h_,qb,T.Q,T.K,T.V,T.O,lds,tid_,t0); }
  }
}
#undef SBAR
#undef WAIT_BAR
}

__global__ void __launch_bounds__(NTHR, 2) mk_fwd(Args args) {
    extern __shared__ __attribute__((aligned(16))) unsigned char lds[];
    Frame F;
    F.lds = (LAS unsigned char*)lds;
    F.tid = threadIdx.x; F.lane = F.tid & 63; F.wave = __builtin_amdgcn_readfirstlane(F.tid >> 6);
    F.G = gridDim.x; { const int bx = blockIdx.x; F.vcu = (F.G % 8 == 0) ? (bx % 8) * (F.G / 8) + bx / 8 : bx; }
    F.ws = args.ws; unsigned char* ws = args.ws;
    F.ctl = (gu32*)(ws + WS_CTL);
    volatile LAS unsigned* MISC = (volatile LAS unsigned*)(F.lds + MISC_OFF);
    for (int u = F.tid; u < (LDS_BYTES - LDSCTL_OFF) / 4; u += NTHR) ((LAS unsigned*)(F.lds + LDSCTL_OFF))[u] = 0u;
    __syncthreads();
    const int lo = args.ph_lo, hi = args.ph_hi;
    XcdBarrier bar; bar.bar = (unsigned*)(F.ctl + CW_BAR); bar.x = 0; bar.st = nullptr; bar.t0 = 0;
    if (hi - lo > 1) bar = xcd_barrier_post((unsigned*)(F.ctl + CW_BAR), MISC + 8, F.tid == 0);
#define FRESH() do { int t_ = tid_of(F.wave); asm volatile("" : "+v"(t_)); F.tid = t_; F.lane = t_ & 63; unsigned char* w_ = args.ws; asm volatile("" : "+s"(w_)); ws = w_; F.ws = w_; } while (0)
#define IN(k) (lo <= (k) && (k) < hi)
#define SEAM(k) do { if (IN(k) && IN((k) + 1)) xcd_barrier(bar, F.wave == 0 && lane_id_() == 0); } while (0)
    const int gw = F.vcu * NWAVES + F.wave, NGW = F.G * NWAVES;
    LAS int* tend = (LAS int*)(F.lds + TEND_OFF); LAS int* tbase = tend + 32;

#define XB ((bf16*)(ws + WS_XB))
#define XB2 ((bf16*)(ws + WS_XB2))
#define PP ((bf16*)(ws + WS_PP))
#define R0 ((bf16*)(ws + WS_PROJ))
#define R1 ((bf16*)(ws + WS_PROJ + PROJ_REGION))
#define R2 ((bf16*)(ws + WS_PROJ + 2 * PROJ_REGION))
#define R3 ((bf16*)(ws + WS_PROJ + 3 * PROJ_REGION))
#define HB ((bf16*)(ws + WS_H))
#define YB ((bf16*)(ws + WS_Y))
#define LOGITS ((float*)(ws + WS_LOGITS))
#define TOKE ((int*)(ws + WS_TOKE))
#define TOKG ((float*)(ws + WS_TOKG))
#define TOKLP ((int*)(ws + WS_TOKLP))
#define TOKPOS ((int*)(ws + WS_TOKPOS))
#define ROWGATE ((float*)(ws + WS_ROWGATE))
#define WGOFF ((int*)(ws + WS_WGOFF))
#define CUM ((float*)(ws + WS_CUM))
#define XF8 (ws + WS_XF8)
#define Y8 (ws + WS_Y)
#define H8 (ws + WS_H)

    if (IN(0)) { FRESH(); p0_prologue(F, args); }
    SEAM(0);

    for (int L = 0; L < DEPTH; ++L) {
        const int kind = (L == 3) ? 0 : L;
        const int P = 1 + 12 * L;
#define gcnt ((gu32*)(ws + WS_CTL) + CW_CNT + 32 * 64 * L)

        if (IN(P + 0)) { FRESH();
            const int npass = (kind == 1) ? 3 : 2;
            for (int pass = 0; pass < npass; ++pass) {
                pg8::Gemm g; pg8::EpiBf16 E; pg8::StaticOrder S; int Mg, Ng;
                if (pass == 0) {
                    Mg = T; Ng = (kind == 0) ? 3 * D : (kind == 1 ? 2 * D : 3 * D + 256);
                    g = pg8::Gemm{XB2, (const bf16*)(ws + WS_WIN + (size_t)L * WIN_STRIDE), D, 0}; E = pg8::EpiBf16{R0, D, D, PROJ_REGION / 2, (kind == 0) ? 1.0f : C2};
                } else if (pass == 1) {
                    Mg = T; Ng = D;
                    g = pg8::Gemm{(const bf16*)(ws + WS_PB) + (size_t)L * T * PLE, (const bf16*)(ws + WS_WPP) + (size_t)L * D * PLE, PLE, 0}; E = pg8::EpiBf16{PP, D, 0, 0, 1.0f};
                } else {
                    Mg = D; Ng = T;
                    g = pg8::Gemm{(const bf16*)(ws + WS_WIN + (size_t)L * WIN_STRIDE) + (size_t)in_vrow0(L) * D, XB2, D, 0}; E = pg8::EpiBf16{R3, T, 0, 0, 1.0f};
                }
                S.init(Mg, Ng, F.G, (int)blockIdx.x);
                pg8::gemm_phase<pg8::EpiBf16, pg8::StaticOrder, true>(F.lds + RING_OFF, g, S, E, F.wave);
            }
        }
        SEAM(P + 0);


        if (IN(P + 2)) { {
            if (kind == 0) { FRESH();
                const float* cw = args.in[3] + (size_t)(L == 3 ? 1 : 0) * 3 * D;
                const int cg = F.tid & 127, rg = F.tid >> 7, ch = cg * 8;
                float w0[8], w1[8], w2[8];
#pragma unroll
                for (int i = 0; i < 8; ++i) { w0[i] = cw[ch + i]; w1[i] = cw[D + ch + i]; w2[i] = cw[2 * D + ch + i]; }
                for (int blk = F.vcu; blk < T / 64; blk += F.G) {
                    const int t0 = blk * 64 + rg * 16;
                    float u1[8], u2[8];
                    if ((t0 & (SEQ - 1)) == 0) {
#pragma unroll
                        for (int i = 0; i < 8; ++i) { u1[i] = 0.f; u2[i] = 0.f; }
                    } else {
                        const v4u c1 = *(const GAS v4u*)(R1 + (size_t)(t0 - 1) * D + ch), h1 = *(const GAS v4u*)(R2 + (size_t)(t0 - 1) * D + ch);
                        const v4u c2 = *(const GAS v4u*)(R1 + (size_t)(t0 - 2) * D + ch), h2 = *(const GAS v4u*)(R2 + (size_t)(t0 - 2) * D + ch);
#pragma unroll
                        for (int i = 0; i < 4; ++i) { u1[2 * i] = bflo(c1[i]) * bflo(h1[i]); u1[2 * i + 1] = bfhi(c1[i]) * bfhi(h1[i]); u2[2 * i] = bflo(c2[i]) * bflo(h2[i]); u2[2 * i + 1] = bfhi(c2[i]) * bfhi(h2[i]); }
                    }
                    for (int r = 0; r < 16; ++r) {
                        const size_t off = (size_t)(t0 + r) * D + ch;
                        const v4u bv = *(const GAS v4u*)(R0 + off), cv = *(const GAS v4u*)(R1 + off), hv = *(const GAS v4u*)(R2 + off);
                        float u0[8], o[8];
#pragma unroll
                        for (int i = 0; i < 4; ++i) { u0[2 * i] = bflo(cv[i]) * bflo(hv[i]); u0[2 * i + 1] = bfhi(cv[i]) * bfhi(hv[i]); }
#pragma unroll
                        for (int i = 0; i < 4; ++i) {
                            o[2 * i] = bflo(bv[i]) * (w0[2 * i] * u2[2 * i] + w1[2 * i] * u1[2 * i] + w2[2 * i] * u0[2 * i]);
                            o[2 * i + 1] = bfhi(bv[i]) * (w0[2 * i + 1] * u2[2 * i + 1] + w1[2 * i + 1] * u1[2 * i + 1] + w2[2 * i + 1] * u0[2 * i + 1]); }
                        v4u ov; ov.x = pk2(o[0], o[1]); ov.y = pk2(o[2], o[3]); ov.z = pk2(o[4], o[5]); ov.w = pk2(o[6], o[7]);
                        *(GAS v4u*)(XB + off) = ov;
#pragma unroll
                        for (int i = 0; i < 8; ++i) { u2[i] = u1[i]; u1[i] = u0[i]; }
                    }
                }
            } else if (kind == 1) { FRESH();
                sb_phase(F, R0, R1, R3, XB);
            } else {
                const attn_body::AttnTensors AT{R0, R1, R2, XB}; const attn_body::FoxOrder FO{F.vcu, F.G};
                attn_body::fox_phase<32>((char*)lds + RING_OFF, AT, R3, args.in[8], FO, F.wave);
            }
        } }
        SEAM(P + 2);

        if (IN(P + 3)) { FRESH();
            pg8::Gemm g{XB, (const bf16*)(ws + WS_WOUT) + (size_t)L * D * D, D, 0}; pg8::StaticOrder S; S.init(T, D, F.G, (int)blockIdx.x);
            pg8::EpiResBf16 E{XB2, R0, D, DN_ALPHA};
            pg8::gemm_phase<pg8::EpiResBf16, pg8::StaticOrder, true>(F.lds + RING_OFF, g, S, E, F.wave);
        }
        SEAM(P + 3);

        if (IN(P + 4)) { FRESH();
            const float* g1 = args.in[10] + (size_t)L * D; const float* b1 = args.in[11] + (size_t)L * D;
            for (int m = gw; m < T; m += 4 * NGW) { v2u yy[4][4];
#pragma unroll
                for (int q = 0; q < 4; ++q)
#pragma unroll
                    for (int j = 0; j < 4; ++j) yy[q][j] = *(const GAS v2u*)(R0 + (size_t)(m + q * NGW) * D + 4 * (64 * j + F.lane));
#pragma unroll
                for (int q = 0; q < 4; ++q) { f32x4 v[4];
#pragma unroll
                    for (int j = 0; j < 4; ++j) v[j] = (f32x4){bflo(yy[q][j].x), bfhi(yy[q][j].x), bflo(yy[q][j].y), bfhi(yy[q][j].y)};
                    ln_store(v, nullptr, XB + (size_t)(m + q * NGW) * D, XF8 + (size_t)(m + q * NGW) * D, g1, b1, F.lane); } }
        }
        SEAM(P + 4);

        if (IN(P + 5)) { FRESH();
            LAS float* part = (LAS float*)(F.lds + RING_OFF);
            LAS int* hist = (LAS int*)(F.lds + RING_OFF + 2 * 128 * 33 * 4);
            const float* rb = args.in[15] + (size_t)L * NE;
            const int rbk = F.wave & 3, kh = F.wave >> 2, r32 = F.lane & 31, hi = F.lane >> 5;
            for (int tb = F.vcu; tb < T / 128; tb += F.G) {
                if (F.tid < 32) hist[F.tid] = 0;
                {
                  const bf16* ap = (const bf16*)(ws + WS_WR) + (size_t)L * 256 * D + (size_t)r32 * D + 512 * kh + 8 * hi;
                  const bf16* bp = XB + (size_t)(tb * 128 + 32 * rbk + r32) * D + 512 * kh + 8 * hi;
                  f32x16 acc;
#pragma unroll
                  for (int r = 0; r < 16; ++r) acc[r] = 0.f;
#pragma unroll 8
                  for (int kk = 0; kk < 32; ++kk) { const bf16x8 a_ = *(const GAS bf16x8*)(ap + 16 * kk), b_ = *(const GAS bf16x8*)(bp + 16 * kk); acc = __builtin_amdgcn_mfma_f32_32x32x16_bf16(a_, b_, acc, 0, 0, 0); }
#pragma unroll
                  for (int r = 0; r < 16; ++r) part[(kh * 128 + 32 * rbk + r32) * 33 + crow(r, hi)] = acc[r]; }
                __syncthreads();
                if (F.tid < 128) {
                    const int t = tb * 128 + F.tid; float v[32];
#pragma unroll
                    for (int j = 0; j < 32; ++j) v[j] = part[F.tid * 33 + j] + part[(128 + F.tid) * 33 + j] + rb[j];
                    int ek[4]; float vk[4];
#pragma unroll
                    for (int k = 0; k < 4; ++k) { float best = v[0]; int bi = 0;
#pragma unroll
                        for (int j = 1; j < 32; ++j) if (v[j] > best) { best = v[j]; bi = j; }
#pragma unroll
                        for (int j = 0; j < 32; ++j) if (j == bi) v[j] = -INFINITY;
                        ek[k] = bi; vk[k] = best; }
                    float ex[4], se = 0.f;
#pragma unroll
                    for (int k = 0; k < 4; ++k) { ex[k] = expf(vk[k] - vk[0]); se += ex[k]; }
                    const float inv = 1.0f / se;
#pragma unroll
                    for (int k = 0; k < 4; ++k) { const int lp = __hip_atomic_fetch_add(hist + ek[k], 1, __ATOMIC_RELAXED, __HIP_MEMORY_SCOPE_WORKGROUP);
                        TOKE[t * 4 + k] = ek[k]; TOKG[t * 4 + k] = ex[k] * inv; TOKLP[t * 4 + k] = lp; }
                }
                __syncthreads();
                if (F.tid < 32) { const int c = hist[F.tid]; const unsigned off = __hip_atomic_fetch_add(gcnt + 64 * F.tid, (unsigned)c, RLX_AGENT); WGOFF[tb * 32 + F.tid] = (int)off; }
                __syncthreads();
            }
        }
        SEAM(P + 5);

        const bool need_tab = IN(P + 7) || IN(P + 8) || IN(P + 9);
        if (need_tab) { FRESH();
            if (F.tid < 64) { const int c = (F.lane < 32) ? (int)__hip_atomic_load(gcnt + 64 * (F.lane & 31), RLX_AGENT) : 0; const int tl = (c + 255) >> 8; int inc = tl;
#pragma unroll
                for (int o = 1; o < 32; o <<= 1) { const int v = shfl_i(inc, F.lane - o); if (F.lane >= o) inc += v; }
                if (F.lane < 32) { tend[F.lane] = inc; tbase[F.lane] = (inc - tl) * 256; } }
            __syncthreads();
        }
        if (IN(P + 7)) { { FRESH();
            LAS int* rowl = (LAS int*)(F.lds + RING_OFF);
            for (int tb = F.vcu; tb < T / 128; tb += F.G) {
                { const int t = tb * 128 + (F.tid >> 2), k = F.tid & 3; const int e = TOKE[t * 4 + k];
                  const int row = tbase[e] + WGOFF[tb * 32 + e] + TOKLP[t * 4 + k];
                  ROWGATE[row] = TOKG[t * 4 + k]; TOKPOS[t * 4 + k] = row; rowl[F.tid] = row; }
                __syncthreads();
                for (int i0 = 0; i0 < 16; i0 += 8) { v4u tv[8];
#pragma unroll
                    for (int i = 0; i < 8; ++i) tv[i] = *((const GAS v4u*)(XF8 + (size_t)(tb * 128 + F.wave * 16 + i0 + i) * D) + F.lane);
#pragma unroll
                    for (int i = 0; i < 8; ++i)
#pragma unroll
                        for (int k = 0; k < 4; ++k) { const int row = rowl[(F.wave * 16 + i0 + i) * 4 + k]; *((GAS v4u*)(Y8 + (size_t)row * D) + F.lane) = tv[i]; } }
                __syncthreads();
            }
        } }
        SEAM(P + 7);

        if (IN(P + 8)) { {
            pg8::Gemm g{(const bf16*)Y8, (const bf16*)(ws + WS_WGU + (size_t)L * NE * 2 * D * D), D, (size_t)2 * D * D}; FRESH(); pg8::MoeOrder S; S.init(tend[31], 2 * D, F.G, (int)blockIdx.x, tend + (F.lane & 31));
            pg8::EpiSwiglu E{H8, args.in[17] + (size_t)L * NE * D, args.in[19] + (size_t)L * NE * D, 1.0f / WGU_SCALE};
            pg8::gemm_phase<pg8::EpiSwiglu, pg8::MoeOrder, true, true>(F.lds + RING_OFF, g, S, E, F.wave);
        } }
        SEAM(P + 8);

        if (IN(P + 9)) { {
            pg8::Gemm g{(const bf16*)H8, (const bf16*)(ws + WS_WD + (size_t)L * NE * D * D), D, (size_t)D * D}; FRESH(); pg8::MoeOrder S; S.init(tend[31], D, F.G, (int)blockIdx.x, tend + (F.lane & 31));
            pg8::EpiDown E{Y8, args.in[21] + (size_t)L * NE * D, ROWGATE, 1.0f / WD_SCALE, Y_SCALE};
            pg8::gemm_phase<pg8::EpiDown, pg8::MoeOrder, true, true>(F.lds + RING_OFF, g, S, E, F.wave);
        } }
        SEAM(P + 9);

        if (IN(P + 10)) { FRESH();
            const float* g2 = args.in[12] + (size_t)L * D; const float* b2 = args.in[13] + (size_t)L * D;
            for (int m = gw; m < T; m += 2 * NGW) { const int m2 = m + NGW; f32x4 v[4], w[4];
                int pos[4], pos2[4];
#pragma unroll
                for (int k = 0; k < 4; ++k) { pos[k] = TOKPOS[m * 4 + k]; pos2[k] = TOKPOS[m2 * 4 + k]; }
                v2u xa[4], xb_[4]; unsigned ya[4][4], yb[4][4];
#pragma unroll
                for (int j = 0; j < 4; ++j) { xa[j] = *(const GAS v2u*)(XB + (size_t)m * D + 4 * (64 * j + F.lane)); xb_[j] = *(const GAS v2u*)(XB + (size_t)m2 * D + 4 * (64 * j + F.lane));
#pragma unroll
                    for (int k = 0; k < 4; ++k) { ya[j][k] = *(const GAS unsigned*)(Y8 + (size_t)pos[k] * D + 4 * (64 * j + F.lane)); yb[j][k] = *(const GAS unsigned*)(Y8 + (size_t)pos2[k] * D + 4 * (64 * j + F.lane)); } }
#pragma unroll
                for (int j = 0; j < 4; ++j) { v[j] = (f32x4){bflo(xa[j].x), bfhi(xa[j].x), bflo(xa[j].y), bfhi(xa[j].y)} * DN_ALPHA; w[j] = (f32x4){bflo(xb_[j].x), bfhi(xb_[j].x), bflo(xb_[j].y), bfhi(xb_[j].y)} * DN_ALPHA;
#pragma unroll
                    for (int k = 0; k < 4; ++k) { const f32x2_ a0 = __builtin_amdgcn_cvt_pk_f32_fp8((int)ya[j][k], false), a1 = __builtin_amdgcn_cvt_pk_f32_fp8((int)ya[j][k], true), c0 = __builtin_amdgcn_cvt_pk_f32_fp8((int)yb[j][k], false), c1 = __builtin_amdgcn_cvt_pk_f32_fp8((int)yb[j][k], true);
                        v[j].x += a0[0] * (1.0f / Y_SCALE); v[j].y += a0[1] * (1.0f / Y_SCALE); v[j].z += a1[0] * (1.0f / Y_SCALE); v[j].w += a1[1] * (1.0f / Y_SCALE);
                        w[j].x += c0[0] * (1.0f / Y_SCALE); w[j].y += c0[1] * (1.0f / Y_SCALE); w[j].z += c1[0] * (1.0f / Y_SCALE); w[j].w += c1[1] * (1.0f / Y_SCALE); } }
                ln_store(v, nullptr, XB + (size_t)m * D, XF8 + (size_t)m * D, g2, b2, F.lane);
                ln_store(w, nullptr, XB + (size_t)m2 * D, XF8 + (size_t)m2 * D, g2, b2, F.lane); }
        }
        SEAM(P + 10);

        if (IN(P + 11)) { FRESH();
            pg8::Gemm g{(const bf16*)XF8, (const bf16*)(ws + WS_WPG + (size_t)L * D * D), D, 0}; pg8::StaticOrder S; S.init(T, D, F.G, (int)blockIdx.x);
            pg8::EpiPle E{XB, (L == DEPTH - 1) ? args.out : nullptr, XB2, PP, args.in[24] + (size_t)L * D, 1.0f / WPG_SCALE};
            pg8::gemm_phase<pg8::EpiPle, pg8::StaticOrder, true, true>(F.lds + RING_OFF, g, S, E, F.wave);
        }
        SEAM(P + 11);
    }
#undef IN
#undef SEAM
#undef gcnt
}

extern "C" void kernel_launch(void* const* d_in, const int* in_sizes, int n_in, void* d_out, int out_size, void* d_ws, size_t ws_size, hipStream_t stream) {
    static int grid = 0;
    if (grid == 0) {
        if (n_in != 25 || in_sizes[0] != T * D || out_size != T * D || ws_size < WS_END) { fprintf(stderr, "kernel_launch: unexpected shapes (n_in %d, in0 %d, out %d, ws %zu < %zu); nothing launched\n", n_in, n_in > 0 ? in_sizes[0] : -1, out_size, ws_size, (size_t)WS_END); grid = -1; return; }
        int dev = 0, cus = 0, per_cu = 0;
        if (hipGetDevice(&dev) != hipSuccess || hipDeviceGetAttribute(&cus, hipDeviceAttributeMultiprocessorCount, dev) != hipSuccess) { grid = -1; return; }
        if (hipFuncSetAttribute((const void*)mk_fwd, hipFuncAttributeMaxDynamicSharedMemorySize, LDS_BYTES) != hipSuccess) { fprintf(stderr, "kernel_launch: hipFuncSetAttribute failed\n"); grid = -1; return; }
        if (hipOccupancyMaxActiveBlocksPerMultiprocessor(&per_cu, (const void*)mk_fwd, NTHR, LDS_BYTES) != hipSuccess || per_cu < 1) fprintf(stderr, "kernel_launch: occupancy query reports %d\n", per_cu);
        (void)hipGetLastError();
        grid = cus;
    }
    if (grid < 0) return;
    if (hipMemsetAsync((char*)d_ws + WS_CTL, 0, CTL_ZERO_BYTES, stream) != hipSuccess) { fprintf(stderr, "kernel_launch: memset failed\n"); return; }
    Args a{};
    for (int i = 0; i < 25; ++i) a.in[i] = (const float*)d_in[i];
    a.out = (float*)d_out; a.ws = (unsigned char*)d_ws;
#if MK_PER_PHASE
    for (int ph = 0; ph < NPH; ++ph) { a.ph_lo = ph; a.ph_hi = ph + 1; hipLaunchKernelGGL(mk_fwd, dim3(grid), dim3(NTHR), LDS_BYTES, stream, a); }
#else
    a.ph_lo = 0; a.ph_hi = NPH;
    hipLaunchKernelGGL(mk_fwd, dim3(grid), dim3(NTHR), LDS_BYTES, stream, a);
#endif
    const hipError_t le = hipPeekAtLastError();
    if (le != hipSuccess) fprintf(stderr, "kernel_launch: launch failed: %s\n", hipGetErrorName(le));
}
```

```cpp
#include <hip/hip_runtime.h>
#include <cstdio>
#include <cstdint>

#ifndef MK_PER_PHASE
#define MK_PER_PHASE 0
#endif

__device__ __forceinline__ int lane_id_() { int l; asm volatile("v_mbcnt_lo_u32_b32 %0, -1, 0\n\tv_mbcnt_hi_u32_b32 %0, -1, %0" : "=v"(l)); return l; }
__device__ __forceinline__ int tid_of(int wave) { return wave * 64 + lane_id_(); }

namespace pg8 {
#define PG8_LAS __attribute__((address_space(3)))
typedef unsigned short bf16_t;
typedef short bf16x8 __attribute__((ext_vector_type(8)));
typedef float f32x4 __attribute__((ext_vector_type(4)));
typedef float f32x2 __attribute__((ext_vector_type(2)));
typedef unsigned u32x4 __attribute__((ext_vector_type(4)));
typedef unsigned u32x2 __attribute__((ext_vector_type(2)));
typedef int i32x4 __attribute__((ext_vector_type(4)));
typedef int i32x8 __attribute__((ext_vector_type(8)));
constexpr int BM = 256, BK = 64, HALF = 128, HTB = HALF * BK * 2  , STAGE_BYTES = 8 * HTB, NXCD = 8, WGM = 8;

__host__ __device__ __forceinline__ int lds_byte(int r, int c) { const int st = (r >> 4) * 2 + (c >> 5), rr = r & 15, cc = c & 31, ob = rr * 64 + cc * 2; return st * 1024 + (ob ^ (((ob >> 9) & 1) << 5)); }
__host__ __device__ __forceinline__ void stage_rc(int b, int& R, int& C) { const int st = b / 1024, sb = b % 1024, swz = sb ^ (((sb >> 9) & 1) << 5); R = (st >> 1) * 16 + swz / 64; C = (st & 1) * 32 + (swz % 64) / 2; }
__host__ __device__ __forceinline__ int perm32(int rho) { const int n = rho >> 4, i = rho & 15; return 8 * (i >> 2) + 4 * n + (i & 3); }

struct Unit { int pm, pn, e; };
struct Gemm { const bf16_t* A; const bf16_t* Bt; int K; size_t bstride; const int* rowtok; };

struct StaticOrder {
    int nM, nN, nwg, G, c;
    __device__ __forceinline__ void init(int M, int N, int G_, int c_) { nM = M / BM; nN = N / BM; nwg = nM * nN; G = G_; c = c_; }
    __device__ __forceinline__ bool map(int i, Unit& u) const {
        const long L = (long)i * G + c; if (L >= nwg) return false;
        int wgid = (int)L; { const int q = nwg / NXCD, r = nwg % NXCD, xcd = wgid % NXCD, off = wgid / NXCD; wgid = (xcd < r ? xcd * (q + 1) : r * (q + 1) + (xcd - r) * q) + off; }
        const int nig = WGM * nN, gid = wgid / nig, fm = gid * WGM, gsz = (nM - fm) < WGM ? (nM - fm) : WGM;
        u.pm = fm + ((wgid % nig) % gsz); u.pn = (wgid % nig) / gsz; return true;
    }
    __device__ __forceinline__ bool next(int i, Unit& u) const { u.e = 0; return map(i, u); }
};
struct MoeOrder {
    StaticOrder so; const PG8_LAS int* tend;
    __device__ __forceinline__ void init(int ntiles, int N, int G_, int c_, const PG8_LAS int* tend_lane) { so.nM = ntiles; so.nN = N / BM; so.nwg = so.nM * so.nN; so.G = G_; so.c = c_; tend = tend_lane; }
    __device__ __forceinline__ bool next(int i, Unit& u) const {
        if (!so.map(i, u)) return false;
        const int te = tend[0];
        const unsigned long long bal = __ballot(te <= u.pm);
        u.e = __builtin_popcount((unsigned)(bal & 0xffffffffull)); if (u.e > 31) u.e = 31;
        return true;
    }
};

__device__ __forceinline__ unsigned cvt_pk_bf16(float lo, float hi) { unsigned r; asm volatile("v_cvt_pk_bf16_f32 %0, %1, %2" : "=v"(r) : "v"(lo), "v"(hi)); return r; }
__device__ __forceinline__ float bf_lo(unsigned w) { return __uint_as_float(w << 16); }
__device__ __forceinline__ float bf_hi(unsigned w) { return __uint_as_float(w & 0xffff0000u); }
__device__ __forceinline__ float sigmoidf_fast(float v) { return __builtin_amdgcn_rcpf(1.0f + __builtin_amdgcn_exp2f(-1.4426950408889634f * v)); }

struct EpiBf16 {
    static constexpr bool PERM = true;
    bf16_t* O; int ldc; int split_cols; size_t split_stride; float scale0;
    __device__ __forceinline__ void operator()(const f32x4 (&acc)[2][2][4][2], const Unit& u, int wr, int wc, int fr, int fq) const {
        const int row0 = u.pm * BM + wr * 64 + fr; int colt = u.pn * BM; bf16_t* base = O;
        float sc = 1.f; if (split_cols) { const int t = colt / split_cols; base += (size_t)t * split_stride; colt -= t * split_cols; if (t == 0) sc = scale0; }
        const int col0 = colt + wc * 64 + 8 * fq;
#pragma unroll
        for (int ai = 0; ai < 2; ++ai)
#pragma unroll
            for (int m = 0; m < 4; ++m) { bf16_t* rowp = base + (size_t)(row0 + ai * HALF + m * 16) * ldc + col0;
#pragma unroll
                for (int bj = 0; bj < 2; ++bj) { f32x4 v0 = acc[ai][bj][m][0] * sc, v1 = acc[ai][bj][m][1] * sc;
                    u32x4 w; w.x = cvt_pk_bf16(v0[0], v0[1]); w.y = cvt_pk_bf16(v0[2], v0[3]); w.z = cvt_pk_bf16(v1[0], v1[1]); w.w = cvt_pk_bf16(v1[2], v1[3]);
                    *(u32x4*)(rowp + bj * 32) = w; } }
    }
};
struct EpiResBf16 {
    static constexpr bool PERM = true;
    const bf16_t* res; bf16_t* out; int ldc; float alpha;
    __device__ __forceinline__ void operator()(const f32x4 (&acc)[2][2][4][2], const Unit& u, int wr, int wc, int fr, int fq) const {
        const int row0 = u.pm * BM + wr * 64 + fr, col0 = u.pn * BM + wc * 64 + 8 * fq;
#pragma unroll
        for (int ai = 0; ai < 2; ++ai)
#pragma unroll
            for (int m = 0; m < 4; ++m) { const size_t off = (size_t)(row0 + ai * HALF + m * 16) * ldc + col0;
#pragma unroll
                for (int bj = 0; bj < 2; ++bj) { const u32x4 r = *(const u32x4*)(res + off + bj * 32); const f32x4 a0 = acc[ai][bj][m][0], a1 = acc[ai][bj][m][1];
                    u32x4 w; w.x = cvt_pk_bf16(bf_lo(r.x) * alpha + a0[0], bf_hi(r.x) * alpha + a0[1]); w.y = cvt_pk_bf16(bf_lo(r.y) * alpha + a0[2], bf_hi(r.y) * alpha + a0[3]);
                    w.z = cvt_pk_bf16(bf_lo(r.z) * alpha + a1[0], bf_hi(r.z) * alpha + a1[1]); w.w = cvt_pk_bf16(bf_lo(r.w) * alpha + a1[2], bf_hi(r.w) * alpha + a1[3]);
                    *(u32x4*)(out + off + bj * 32) = w; }
                asm volatile("" ::: "memory"); }
    }
};
struct EpiRouter {
    static constexpr bool PERM = false;
    float* out;
    __device__ __forceinline__ void operator()(const f32x4 (&acc)[2][2][4][2], const Unit& u, int wr, int wc, int fr, int fq) const {
        if (wc != 0 || u.pn != 0) return;
        const int row0 = u.pm * BM + wr * 64 + fr;
#pragma unroll
        for (int ai = 0; ai < 2; ++ai)
#pragma unroll
            for (int m = 0; m < 4; ++m) { float* rowp = out + (size_t)(row0 + ai * HALF + m * 16) * 32 + 4 * fq;
                *(f32x4*)(rowp) = acc[ai][0][m][0]; *(f32x4*)(rowp + 16) = acc[ai][0][m][1]; }
    }
};
__device__ __forceinline__ unsigned pk4_fp8(float a, float b, float c, float d) { int w = 0; w = __builtin_amdgcn_cvt_pk_fp8_f32(a, b, w, false); w = __builtin_amdgcn_cvt_pk_fp8_f32(c, d, w, true); return (unsigned)w; }
struct EpiSwiglu {
    static constexpr bool PERM = true;
    unsigned char* H; const float* bg; const float* bu; float inv_scale;
    __device__ __forceinline__ void operator()(const f32x4 (&acc)[2][2][4][2], const Unit& u, int wr, int wc, int fr, int fq) const {
        const int row0 = u.pm * BM + wr * 64 + fr, ch0 = u.pn * HALF + wc * 32 + 8 * fq;
        f32x4 gb[2], ub[2];
#pragma unroll
        for (int n = 0; n < 2; ++n) { gb[n] = *(const f32x4*)(bg + (size_t)u.e * 1024 + ch0 + 4 * n); ub[n] = *(const f32x4*)(bu + (size_t)u.e * 1024 + ch0 + 4 * n); }
#pragma unroll
        for (int ai = 0; ai < 2; ++ai)
#pragma unroll
            for (int m = 0; m < 4; ++m) { unsigned char* rowp = H + (size_t)(row0 + ai * HALF + m * 16) * 1024 + ch0; float a[8];
#pragma unroll
                for (int n = 0; n < 2; ++n) { const f32x4 g4 = acc[ai][0][m][n] * inv_scale + gb[n], u4 = acc[ai][1][m][n] * inv_scale + ub[n];
#pragma unroll
                    for (int j = 0; j < 4; ++j) { const float g = fminf(g4[j], 7.0f), uu = fminf(fmaxf(u4[j], -7.0f), 7.0f); a[4 * n + j] = g * sigmoidf_fast(1.702f * g) * (uu + 1.0f); } }
                u32x2 w; w.x = pk4_fp8(a[0], a[1], a[2], a[3]); w.y = pk4_fp8(a[4], a[5], a[6], a[7]);
                *(u32x2*)rowp = w; }
    }
};
struct EpiDown {
    static constexpr bool PERM = true;
    unsigned char* Y; const float* bd; const float* rgate; float inv_scale, yscale;
    __device__ __forceinline__ void operator()(const f32x4 (&acc)[2][2][4][2], const Unit& u, int wr, int wc, int fr, int fq) const {
        const int row0 = u.pm * BM + wr * 64 + fr, col0 = u.pn * BM + wc * 64 + 8 * fq;
        f32x4 bv[2][2];
#pragma unroll
        for (int bj = 0; bj < 2; ++bj)
#pragma unroll
            for (int n = 0; n < 2; ++n) bv[bj][n] = *(const f32x4*)(bd + (size_t)u.e * 1024 + col0 + bj * 32 + 4 * n);
#pragma unroll
        for (int ai = 0; ai < 2; ++ai)
#pragma unroll
            for (int m = 0; m < 4; ++m) { const int row = row0 + ai * HALF + m * 16; const float gt = rgate[row] * yscale; unsigned char* rowp = Y + (size_t)row * 1024 + col0;
#pragma unroll
                for (int bj = 0; bj < 2; ++bj) { const f32x4 v0 = (acc[ai][bj][m][0] * inv_scale + bv[bj][0]) * gt, v1 = (acc[ai][bj][m][1] * inv_scale + bv[bj][1]) * gt;
                    u32x2 w; w.x = pk4_fp8(v0[0], v0[1], v0[2], v0[3]); w.y = pk4_fp8(v1[0], v1[1], v1[2], v1[3]);
                    *(u32x2*)(rowp + bj * 32) = w; } }
    }
};
struct EpiPle {
    static constexpr bool PERM = true;
    const bf16_t* xin; float* xout; bf16_t* xb; const bf16_t* pp; const float* bgate; float inv_scale;
    __device__ __forceinline__ void operator()(const f32x4 (&acc)[2][2][4][2], const Unit& u, int wr, int wc, int fr, int fq) const {
        const int row0 = u.pm * BM + wr * 64 + fr, col0 = u.pn * BM + wc * 64 + 8 * fq;
        f32x4 bv[2][2];
#pragma unroll
        for (int bj = 0; bj < 2; ++bj)
#pragma unroll
            for (int n = 0; n < 2; ++n) bv[bj][n] = *(const f32x4*)(bgate + col0 + bj * 32 + 4 * n);
#pragma unroll
        for (int ai = 0; ai < 2; ++ai)
#pragma unroll
            for (int m = 0; m < 4; ++m) { const size_t off = (size_t)(row0 + ai * HALF + m * 16) * 1024 + col0;
#pragma unroll
                for (int bj = 0; bj < 2; ++bj) { const size_t o2 = off + bj * 32;
                    const u32x4 xw = *(const u32x4*)(xin + o2); const f32x4 x0 = {bf_lo(xw.x), bf_hi(xw.x), bf_lo(xw.y), bf_hi(xw.y)}, x1 = {bf_lo(xw.z), bf_hi(xw.z), bf_lo(xw.w), bf_hi(xw.w)}; const u32x4 pw = *(const u32x4*)(pp + o2);
                    const f32x4 a0 = acc[ai][bj][m][0] * inv_scale + bv[bj][0], a1 = acc[ai][bj][m][1] * inv_scale + bv[bj][1];
                    f32x4 r0, r1;
                    r0[0] = x0[0] + bf_lo(pw.x) * sigmoidf_fast(a0[0]); r0[1] = x0[1] + bf_hi(pw.x) * sigmoidf_fast(a0[1]);
                    r0[2] = x0[2] + bf_lo(pw.y) * sigmoidf_fast(a0[2]); r0[3] = x0[3] + bf_hi(pw.y) * sigmoidf_fast(a0[3]);
                    r1[0] = x1[0] + bf_lo(pw.z) * sigmoidf_fast(a1[0]); r1[1] = x1[1] + bf_hi(pw.z) * sigmoidf_fast(a1[1]);
                    r1[2] = x1[2] + bf_lo(pw.w) * sigmoidf_fast(a1[2]); r1[3] = x1[3] + bf_hi(pw.w) * sigmoidf_fast(a1[3]);
                    if (xout) { *(f32x4*)(xout + o2) = r0; *(f32x4*)(xout + o2 + 4) = r1; }
                    u32x4 w; w.x = cvt_pk_bf16(r0[0], r0[1]); w.y = cvt_pk_bf16(r0[2], r0[3]); w.z = cvt_pk_bf16(r1[0], r1[1]); w.w = cvt_pk_bf16(r1[2], r1[3]);
                    *(u32x4*)(xb + o2) = w; }
                asm volatile("" ::: "memory"); }
    }
};

template <class Epi, class Sched, bool ALIGN_EPI, bool FP8 = false, bool GATHER = false>
__device__ __forceinline__ void gemm_phase(PG8_LAS unsigned char* lds, const Gemm g, const Sched& S, const Epi& E, const int wave_) {
    int tid_ = tid_of(wave_); asm volatile("" : "+v"(tid_));
    const int tid = tid_, wid = __builtin_amdgcn_readfirstlane(tid >> 6), lane = tid & 63, wr = wid >> 2, wc = wid & 3, fr = lane & 15, fq = lane >> 4;
    constexpr int ES = FP8 ? 1 : 2;
    const int K = g.K, nt = K * ES / (BK * 2);
    unsigned voffA[2], voffB[2]; int Rrow[2]; unsigned Cb[2];
#pragma unroll
    for (int i = 0; i < 2; ++i) { int R, C; stage_rc(tid * 16 + i * 8192, R, C); Rrow[i] = R; Cb[i] = (unsigned)(C * 2); const int Rb = Epi::PERM ? ((R & ~31) + perm32(R & 31)) : R;
        voffA[i] = (unsigned)(R * K * ES + C * 2); voffB[i] = (unsigned)((Epi::PERM ? ((Rb >> 5) * 64 + (Rb & 31)) : Rb) * K * ES + C * 2); }
    const size_t kstep = (size_t)(BK * 2);
    const size_t hstep = (size_t)HALF * K * ES;
    const size_t tstep = 2 * hstep;
    const size_t hstepB = Epi::PERM ? (size_t)32 * K * ES : hstep;
    const unsigned ldsw = (unsigned)wid * 1024u;
    const int aoff = lds_byte(wr * 64 + fr, fq * 8), boff = lds_byte(wc * 32 + fr, fq * 8);
#define PG8_SA(b, h) (((b) * 2 + (h)) * HTB)
#define PG8_SB(b, h) ((4 + (b) * 2 + (h)) * HTB)
#define PG8_STAGE(bufoff, gbase, voff) do { _Pragma("unroll") for (int _i = 0; _i < 2; ++_i) \
        __builtin_amdgcn_global_load_lds((const unsigned*)((const char*)(gbase) + (voff)[_i]), (PG8_LAS unsigned*)(lds + (bufoff) + ldsw + _i * 8192), 16, 0, 0); } while (0)
#define PG8_LDA(dst, b, h) do { _Pragma("unroll") for (int m = 0; m < 4; ++m) { const i32x4 lo_ = *(const PG8_LAS i32x4*)(lds + PG8_SA(b, h) + aoff + m * 2048), hi_ = *(const PG8_LAS i32x4*)(lds + PG8_SA(b, h) + aoff + m * 2048 + 1024); dst[m] = __builtin_shufflevector(lo_, hi_, 0, 1, 2, 3, 4, 5, 6, 7); } } while (0)
#define PG8_LDB(dst, b, h) do { _Pragma("unroll") for (int n = 0; n < 2; ++n) { const i32x4 lo_ = *(const PG8_LAS i32x4*)(lds + PG8_SB(b, h) + boff + n * 2048), hi_ = *(const PG8_LAS i32x4*)(lds + PG8_SB(b, h) + boff + n * 2048 + 1024); dst[n] = __builtin_shufflevector(lo_, hi_, 0, 1, 2, 3, 4, 5, 6, 7); } } while (0)
#define PG8_MMA(ai, bj, At, Bt) do { __builtin_amdgcn_s_setprio(1); _Pragma("unroll") for (int m = 0; m < 4; ++m) _Pragma("unroll") for (int n = 0; n < 2; ++n) { \
        if constexpr (FP8) asm volatile("v_mfma_scale_f32_16x16x128_f8f6f4 %0, %1, %2, %0, %3, %3 op_sel_hi:[0,0,0]" : "+v"(acc[ai][bj][m][n]) : "v"(Bt[n]), "v"(At[m]), "v"(scl1));   \
        else { acc[ai][bj][m][n] = __builtin_amdgcn_mfma_f32_16x16x32_bf16(__builtin_bit_cast(bf16x8, __builtin_shufflevector(Bt[n], Bt[n], 0, 1, 2, 3)), __builtin_bit_cast(bf16x8, __builtin_shufflevector(At[m], At[m], 0, 1, 2, 3)), acc[ai][bj][m][n], 0, 0, 0); \
               acc[ai][bj][m][n] = __builtin_amdgcn_mfma_f32_16x16x32_bf16(__builtin_bit_cast(bf16x8, __builtin_shufflevector(Bt[n], Bt[n], 4, 5, 6, 7)), __builtin_bit_cast(bf16x8, __builtin_shufflevector(At[m], At[m], 4, 5, 6, 7)), acc[ai][bj][m][n], 0, 0, 0); } } \
        __builtin_amdgcn_s_setprio(0); } while (0)
#define PG8_WAIT_V(n) asm volatile("s_waitcnt vmcnt(" #n ")" ::: "memory")
#define PG8_WAIT_L(n) asm volatile("s_waitcnt lgkmcnt(" #n ")" ::: "memory")
#define PG8_BAR __builtin_amdgcn_s_barrier()
#define PG8_SCHED __builtin_amdgcn_sched_barrier(0)
    Unit cur, nxt; int ui = 0;
    if (!S.next(0, cur)) return;
    f32x4 acc[2][2][4][2];
#pragma unroll
    for (int a = 0; a < 2; ++a)
#pragma unroll
        for (int b = 0; b < 2; ++b)
#pragma unroll
            for (int m = 0; m < 4; ++m)
#pragma unroll
                for (int n = 0; n < 2; ++n) acc[a][b][m][n] = (f32x4){0.f, 0.f, 0.f, 0.f};
    int scl1 = 0x7f7f7f7f; asm volatile("" : "+v"(scl1));
    i32x8 At[4], B0[2], B1[2];
    const char* cA = GATHER ? (const char*)g.A : (const char*)g.A + (size_t)cur.pm * tstep; const char* cB = (const char*)g.Bt + (size_t)cur.e * g.bstride * ES + (size_t)cur.pn * tstep;
    unsigned gvC[2][2], gvN[2][2]; int tokN[2][2];
    if constexpr (GATHER) {
#pragma unroll
        for (int h = 0; h < 2; ++h)
#pragma unroll
            for (int i = 0; i < 2; ++i) { gvC[h][i] = (unsigned)g.rowtok[cur.pm * BM + h * HALF + Rrow[i]] * (unsigned)(K * ES) + Cb[i]; gvN[h][i] = gvC[h][i]; tokN[h][i] = 0; }
    }
#define PG8_STAGE_A(bufoff, kptr, h, nx) do { if constexpr (GATHER) { if (nx) PG8_STAGE(bufoff, kptr, gvS[h]); else PG8_STAGE(bufoff, kptr, gvC[h]); } else PG8_STAGE(bufoff, (kptr) + (h) * hstep, voffA); } while (0)
    { unsigned (&gvS)[2][2] = gvC;
    PG8_STAGE(PG8_SB(0, 0), cB, voffB); PG8_STAGE(PG8_SB(0, 1), cB + hstepB, voffB); PG8_STAGE_A(PG8_SA(0, 0), cA, 0, false); PG8_STAGE_A(PG8_SA(0, 1), cA, 1, false);
    if (wr == 1) PG8_BAR;
    PG8_WAIT_V(2); PG8_BAR;
    PG8_STAGE(PG8_SB(1, 0), cB + kstep, voffB); PG8_STAGE_A(PG8_SA(1, 0), cA + kstep, 0, false); PG8_STAGE(PG8_SB(1, 1), cB + hstepB + kstep, voffB); }
    PG8_WAIT_V(6); PG8_BAR;
    for (;;) {
        const bool has_next = S.next(ui + 1, nxt);
        const char* nA = (has_next && !GATHER) ? (const char*)g.A + (size_t)nxt.pm * tstep : cA; const char* nB = has_next ? (const char*)g.Bt + (size_t)nxt.e * g.bstride * ES + (size_t)nxt.pn * tstep : cB;
        if constexpr (GATHER) { if (has_next) {
#pragma unroll
            for (int h = 0; h < 2; ++h)
#pragma unroll
                for (int i = 0; i < 2; ++i) asm volatile("global_load_dword %0, %1, off" : "=v"(tokN[h][i]) : "v"(g.rowtok + nxt.pm * BM + h * HALF + Rrow[i]) : "memory"); } }
#pragma nounroll
        for (int t = 0; t < nt; t += 2) {
            const bool last = (t == nt - 2);
            unsigned gvS[2][2];
            if constexpr (GATHER) {
                if (last && has_next) {
#pragma unroll
                    for (int h = 0; h < 2; ++h)
#pragma unroll
                        for (int i = 0; i < 2; ++i) { int tk_ = tokN[h][i]; asm volatile("" : "+v"(tk_));
                            gvN[h][i] = (unsigned)tk_ * (unsigned)(K * ES) + Cb[i]; }
                }
#pragma unroll
                for (int h = 0; h < 2; ++h)
#pragma unroll
                    for (int i = 0; i < 2; ++i) gvS[h][i] = last ? gvN[h][i] : gvC[h][i];
            }
            const char* a1 = cA + (size_t)(t + 1) * kstep;
            const char* a2 = last ? nA : cA + (size_t)(t + 2) * kstep; const char* b2 = last ? nB : cB + (size_t)(t + 2) * kstep;
            const char* a3 = a2 + kstep; const char* b3 = b2 + kstep;
            PG8_LDB(B0, 0, 0); PG8_LDB(B1, 0, 1); PG8_SCHED; PG8_LDA(At, 0, 0); PG8_STAGE_A(PG8_SA(1, 1), a1, 1, false);
            PG8_WAIT_V(8); PG8_WAIT_L(0); PG8_BAR; PG8_MMA(0, 0, At, B0); PG8_MMA(0, 1, At, B1); PG8_BAR; PG8_SCHED;
            PG8_LDA(At, 0, 1); PG8_STAGE(PG8_SB(0, 0), b2, voffB); PG8_STAGE(PG8_SB(0, 1), b2 + hstepB, voffB); PG8_STAGE_A(PG8_SA(0, 0), a2, 0, true);
            PG8_WAIT_V(8); PG8_WAIT_L(0); PG8_BAR; PG8_MMA(1, 0, At, B0); PG8_MMA(1, 1, At, B1); PG8_BAR; PG8_SCHED;
            PG8_LDB(B0, 1, 0); PG8_LDB(B1, 1, 1); PG8_SCHED; PG8_LDA(At, 1, 0); PG8_STAGE_A(PG8_SA(0, 1), a2, 1, true);
            PG8_WAIT_V(8); PG8_WAIT_L(0); PG8_BAR; PG8_MMA(0, 0, At, B0); PG8_MMA(0, 1, At, B1); PG8_BAR; PG8_SCHED;
            PG8_LDA(At, 1, 1); PG8_STAGE(PG8_SB(1, 0), b3, voffB); PG8_STAGE(PG8_SB(1, 1), b3 + hstepB, voffB); PG8_STAGE_A(PG8_SA(1, 0), a3, 0, true);
            PG8_WAIT_V(8); PG8_WAIT_L(0); PG8_BAR; PG8_MMA(1, 0, At, B0); PG8_MMA(1, 1, At, B1); PG8_BAR; PG8_SCHED;
        }
        if constexpr (ALIGN_EPI) { if (wr == 0) PG8_BAR; }
        if constexpr (FP8) {
            asm volatile("s_nop 15\n\ts_nop 15" : "+v"(acc[0][0][0][0]), "+v"(acc[0][0][0][1]), "+v"(acc[0][0][1][0]), "+v"(acc[0][0][1][1]), "+v"(acc[0][0][2][0]), "+v"(acc[0][0][2][1]), "+v"(acc[0][0][3][0]), "+v"(acc[0][0][3][1]),
                         "+v"(acc[0][1][0][0]), "+v"(acc[0][1][0][1]), "+v"(acc[0][1][1][0]), "+v"(acc[0][1][1][1]), "+v"(acc[0][1][2][0]), "+v"(acc[0][1][2][1]), "+v"(acc[0][1][3][0]), "+v"(acc[0][1][3][1]));
            asm volatile("s_nop 0" : "+v"(acc[1][0][0][0]), "+v"(acc[1][0][0][1]), "+v"(acc[1][0][1][0]), "+v"(acc[1][0][1][1]), "+v"(acc[1][0][2][0]), "+v"(acc[1][0][2][1]), "+v"(acc[1][0][3][0]), "+v"(acc[1][0][3][1]),
                         "+v"(acc[1][1][0][0]), "+v"(acc[1][1][0][1]), "+v"(acc[1][1][1][0]), "+v"(acc[1][1][1][1]), "+v"(acc[1][1][2][0]), "+v"(acc[1][1][2][1]), "+v"(acc[1][1][3][0]), "+v"(acc[1][1][3][1])); }
        E(acc, cur, wr, wc, fr, fq);
        if (!has_next) break;
#pragma unroll
        for (int a = 0; a < 2; ++a)
#pragma unroll
            for (int b = 0; b < 2; ++b)
#pragma unroll
                for (int m = 0; m < 4; ++m)
#pragma unroll
                    for (int n = 0; n < 2; ++n) acc[a][b][m][n] = (f32x4){0.f, 0.f, 0.f, 0.f};
        cur = nxt; cA = nA; cB = nB; ++ui;
        if constexpr (GATHER) {
#pragma unroll
            for (int h = 0; h < 2; ++h)
#pragma unroll
                for (int i = 0; i < 2; ++i) gvC[h][i] = gvN[h][i]; }
        if constexpr (ALIGN_EPI) { if (wr == 1) PG8_BAR; }
    }
    PG8_WAIT_V(0);
    if constexpr (!ALIGN_EPI) { if (wr == 0) PG8_BAR; }
    PG8_BAR;
#undef PG8_SA
#undef PG8_SB
#undef PG8_STAGE
#undef PG8_STAGE_A
#undef PG8_LDA
#undef PG8_LDB
#undef PG8_MMA
#undef PG8_WAIT_V
#undef PG8_WAIT_L
#undef PG8_BAR
#undef PG8_SCHED
}
}

constexpr int NWAVES = 8, NTHR = NWAVES * 64;
constexpr int BATCH = 8, SEQ = 4096, D = 1024, NH = 16, HD = 64, DEPTH = 4, NE = 32, TOPK = 4, PLE = 256;
constexpr int T = BATCH * SEQ;
constexpr float LN_EPS = 1e-5f;
constexpr float DN_ALPHA = 1.6817928305074290f;
constexpr float C2 = 0.125f * 1.4426950408889634f;
constexpr int NR_MAX = T * TOPK + NE * 256;
constexpr int NPH = 1 + 12 * DEPTH;
constexpr float Y_SCALE = 16.0f;
constexpr float WGU_SCALE = 64.0f, WD_SCALE = 128.0f, WPG_SCALE = 32.0f;

constexpr size_t MiB = 1u << 20;
constexpr size_t WS_CTL = 0, CTL_ZERO_BYTES = 1 * MiB;
constexpr size_t WS_WIN = 2 * MiB, WIN_STRIDE = 7 * MiB;
constexpr size_t WS_WOUT = 30 * MiB, WS_WR = 38 * MiB, WS_WPP = 40 * MiB, WS_WPG = 42 * MiB;
constexpr size_t WS_WGU = 64 * MiB, WS_WD = 576 * MiB;
constexpr size_t WS_X = 832 * MiB, WS_XB = 960 * MiB, WS_PB = 1024 * MiB, WS_PP = 1088 * MiB;
constexpr size_t WS_PROJ = 1152 * MiB, PROJ_REGION = 64 * MiB;
constexpr size_t WS_H = WS_PROJ;
constexpr size_t WS_Y = 1424 * MiB;
constexpr size_t WS_MISC = 1696 * MiB;
constexpr size_t WS_LOGITS = WS_MISC, WS_TOKE = WS_MISC + 4 * MiB, WS_TOKG = WS_TOKE + MiB / 2, WS_TOKLP = WS_TOKG + MiB / 2, WS_TOKPOS = WS_TOKLP + MiB / 2,
                 WS_ROWGATE = WS_TOKPOS + MiB / 2, WS_WGOFF = WS_ROWGATE + MiB, WS_CUM = WS_WGOFF + MiB, WS_XB2 = WS_CUM + 2 * MiB, WS_XF8 = WS_XB2 + 64 * MiB, WS_ROWTOK = WS_XF8 + 32 * MiB, WS_END = WS_ROWTOK + MiB;
static_assert(WS_H + (size_t)NR_MAX * 1024 * 2 <= WS_Y && WS_Y + (size_t)NR_MAX * 1024 * 2 <= WS_MISC, "ws map");
constexpr int CW_BAR = 4096;
constexpr int CW_CNT = 16384;

constexpr int RING_OFF = 0, RING_BYTES = 131072;
constexpr int LDSCTL_OFF = RING_BYTES, MISC_OFF = LDSCTL_OFF + 320;
constexpr int TEND_OFF = LDSCTL_OFF + 1024;
constexpr int LDS_BYTES = 147456;

#define GAS __attribute__((address_space(1)))
#define LAS __attribute__((address_space(3)))
typedef unsigned short bf16;
typedef unsigned v4u __attribute__((ext_vector_type(4)));
typedef unsigned v2u __attribute__((ext_vector_type(2)));
typedef float f32x4 __attribute__((ext_vector_type(4)));
typedef float f32x16 __attribute__((ext_vector_type(16)));
typedef float f32x2_ __attribute__((ext_vector_type(2)));
typedef short bf16x8 __attribute__((ext_vector_type(8)));
typedef short s16x4 __attribute__((ext_vector_type(4)));
typedef GAS unsigned gu32;
#define RLX_AGENT __ATOMIC_RELAXED, __HIP_MEMORY_SCOPE_AGENT
#define LDS_WAIT() asm volatile("s_waitcnt lgkmcnt(0)" ::: "memory")
#define VM_WAIT() asm volatile("s_waitcnt vmcnt(0)" ::: "memory")
__device__ __forceinline__ unsigned f2bf(float f) { unsigned u = __builtin_bit_cast(unsigned, f); return (u + 0x7fffu + ((u >> 16) & 1u)) >> 16; }
__device__ __forceinline__ unsigned pk2(float lo, float hi) { return f2bf(lo) | (f2bf(hi) << 16); }
__device__ __forceinline__ float bflo(unsigned w) { return __uint_as_float(w << 16); }
__device__ __forceinline__ float bfhi(unsigned w) { return __uint_as_float(w & 0xffff0000u); }

#define XB_TMO      128
#define XB_XCNT(j)  (256  + 64 * (j))
#define XB_XSUB(j)  (1280 + 64 * (j))
#define XB_XGEN(j)  (2304 + 64 * (j))
#define XB_TOP      3328
#define XB_TOPGEN   3392
#define XCD_BAR_WORDS 3456
#define XB_SPIN_CAP (1u << 18)

__device__ __forceinline__ unsigned xb_ld(unsigned* p)              { return __hip_atomic_load(p, __ATOMIC_RELAXED, __HIP_MEMORY_SCOPE_AGENT); }
__device__ __forceinline__ unsigned xb_add(unsigned* p, unsigned v) { return __hip_atomic_fetch_add(p, v, __ATOMIC_RELAXED, __HIP_MEMORY_SCOPE_AGENT); }
__device__ __forceinline__ unsigned xb_xcc_id() { return (unsigned)__builtin_amdgcn_s_getreg((3 << 11) | 20) & 0xFu; }
#define XB_SPIN(cond, bar) do { unsigned _sp = 0; while (cond) { __builtin_amdgcn_s_sleep(1); \
    if ((++_sp & 255u) == 0u) { if (xb_ld(&(bar)[XB_TMO])) break; if (_sp > XB_SPIN_CAP) { atomicAdd(&(bar)[XB_TMO], 1u); break; } } } } while (0)

struct XcdBarrier { unsigned* bar; unsigned x; volatile LAS unsigned* st; int t0; };

__device__ __forceinline__ XcdBarrier xcd_barrier_post(unsigned* bar, volatile LAS unsigned* st, bool is_t0) {
    XcdBarrier b; b.bar = bar; b.x = xb_xcc_id(); b.st = st; b.t0 = 0;
    if (is_t0) (void)xb_add(&bar[XB_XCNT(b.x)], 1u);
    return b;
}
__device__ __forceinline__ void xcd_barrier_complete(unsigned* bar, unsigned x, unsigned& nloc, unsigned& nx) {
    const unsigned G = gridDim.x * gridDim.y * gridDim.z;
    unsigned sum, cnt, mine, sp = 0u;
    for (;;) {
        sum = 0u; cnt = 0u; mine = 0u;
#pragma unroll
        for (unsigned j = 0; j < 16; ++j) { const unsigned c = xb_ld(&bar[XB_XCNT(j)]); sum += c; cnt += (c > 0u) ? 1u : 0u; mine = (j == x) ? c : mine; }
        if (sum == G) break;
        __builtin_amdgcn_s_sleep(1);
        if ((++sp & 255u) == 0u) { if (xb_ld(&bar[XB_TMO])) break; if (sp > XB_SPIN_CAP) { atomicAdd(&bar[XB_TMO], 1u); break; } }
    }
    nloc = mine > 0u ? mine : 1u; nx = cnt > 0u ? cnt : 1u;
}
__device__ __forceinline__ void xcd_barrier(const XcdBarrier& b, bool is_t0) {
    asm volatile("s_waitcnt vmcnt(0)" ::: "memory");
    __syncthreads();
    if (is_t0) {
        unsigned* bar = b.bar;
        __builtin_amdgcn_s_waitcnt(0);
        unsigned nloc = b.st[0], nx = b.st[1];
        if (nloc == 0u) { xcd_barrier_complete(bar, b.x, nloc, nx); b.st[0] = nloc; b.st[1] = nx; }
        const unsigned old = xb_add(&bar[XB_XSUB(b.x)], 1u);
        const unsigned gen = old / nloc;
        if (old + 1u == (gen + 1u) * nloc) {
            __builtin_amdgcn_fence(__ATOMIC_RELEASE, "agent");
            asm volatile("s_waitcnt vmcnt(0)" ::: "memory");
            const unsigned og = xb_add(&bar[XB_TOP], 1u);
            const unsigned tg = og / nx;
            if (og + 1u == (tg + 1u) * nx) xb_add(&bar[XB_TOPGEN], 1u);
            else XB_SPIN(xb_ld(&bar[XB_TOPGEN]) == tg, bar);
            __builtin_amdgcn_fence(__ATOMIC_ACQUIRE, "agent");
            xb_add(&bar[XB_XGEN(b.x)], 1u);
            asm volatile("s_waitcnt vmcnt(0)" ::: "memory");
        } else {
            XB_SPIN(xb_ld(&bar[XB_XGEN(b.x)]) == gen, bar);
            __builtin_amdgcn_fence(__ATOMIC_ACQUIRE, "agent");
            asm volatile("s_waitcnt vmcnt(0)" ::: "memory");
        }
    }
    __syncthreads();
}

struct Args { const float* in[25]; float* out; unsigned char* ws; int ph_lo, ph_hi; };
struct Frame {
    LAS unsigned char* lds;
    gu32* ctl;
    int tid, lane, wave, vcu, G;
    unsigned char* ws;
};

__device__ __forceinline__ float shfl_f(float v, int src_lane) { return __int_as_float(__builtin_amdgcn_ds_bpermute(src_lane << 2, __float_as_int(v))); }
__device__ __forceinline__ int shfl_i(int v, int src_lane) { return __builtin_amdgcn_ds_bpermute(src_lane << 2, v); }
__device__ __forceinline__ float wave_sum(float v, int lane) {
#pragma unroll
    for (int o = 1; o < 64; o <<= 1) v += shfl_f(v, lane ^ o);
    return v;
}
__device__ __forceinline__ void transpose_item(const float* W, int ldw, int K, bf16* WT, int k0, int n0, int drow0, LAS float* scr, int lane) {
    { const int r_ = lane >> 3, q_ = lane & 7; f32x4 v_[8];
#pragma unroll
      for (int i = 0; i < 8; ++i) v_[i] = *(const GAS f32x4*)(W + (size_t)(k0 + 8 * i + r_) * ldw + n0 + 4 * q_);
#pragma unroll
      for (int i = 0; i < 8; ++i) { LAS float* d_ = scr + (8 * i + r_) * 33 + 4 * q_; d_[0] = v_[i].x; d_[1] = v_[i].y; d_[2] = v_[i].z; d_[3] = v_[i].w; } }
    LDS_WAIT(); asm volatile("" ::: "memory");
    const int c = lane & 7;
#pragma unroll
    for (int j = 0; j < 4; ++j) { const int n = (lane >> 3) + 8 * j; const LAS float* s = scr + (8 * c) * 33 + n;
        v4u o; o.x = pk2(s[0 * 33], s[1 * 33]); o.y = pk2(s[2 * 33], s[3 * 33]); o.z = pk2(s[4 * 33], s[5 * 33]); o.w = pk2(s[6 * 33], s[7 * 33]);
        *(GAS v4u*)(WT + (size_t)(drow0 + n) * K + k0 + 8 * c) = o; }
    LDS_WAIT(); asm volatile("" ::: "memory");
}
struct TileRegs { f32x4 v[8]; };
__device__ __forceinline__ void tile_load(TileRegs& t, const float* W, int ldw, int k0, int n0, int lane) {
    const int r_ = lane >> 3, q_ = lane & 7;
#pragma unroll
    for (int i = 0; i < 8; ++i) t.v[i] = *(const GAS f32x4*)(W + (size_t)(k0 + 8 * i + r_) * ldw + n0 + 4 * q_);
}
__device__ __forceinline__ void tile_store8(const TileRegs& t, int K, unsigned char* WT, int k0, int drow0, float scale, LAS float* scr, int lane) {
    { const int r_ = lane >> 3, q_ = lane & 7;
#pragma unroll
      for (int i = 0; i < 8; ++i) { LAS float* d_ = scr + (8 * i + r_) * 33 + 4 * q_; d_[0] = t.v[i].x; d_[1] = t.v[i].y; d_[2] = t.v[i].z; d_[3] = t.v[i].w; } }
    LDS_WAIT(); asm volatile("" ::: "memory");
    const int c = lane & 7;
#pragma unroll
    for (int j = 0; j < 4; ++j) { const int n = (lane >> 3) + 8 * j; const LAS float* s = scr + (8 * c) * 33 + n;
        v2u o; o.x = pg8::pk4_fp8(s[0 * 33] * scale, s[1 * 33] * scale, s[2 * 33] * scale, s[3 * 33] * scale); o.y = pg8::pk4_fp8(s[4 * 33] * scale, s[5 * 33] * scale, s[6 * 33] * scale, s[7 * 33] * scale);
        *(GAS v2u*)(WT + (size_t)(drow0 + n) * K + k0 + 8 * c) = o; }
    LDS_WAIT(); asm volatile("" ::: "memory");
}
__device__ __forceinline__ int in_vrow0(int L) { return 2048; }

__device__ __forceinline__ void p0_prologue(Frame& F, const Args& a) {
    LAS float* scr = (LAS float*)(F.lds + RING_OFF + F.wave * 16384);
    const int gw = F.vcu * NWAVES + F.wave, NGW = F.G * NWAVES;
    unsigned char* ws = F.ws;
    constexpr int IT_MAT = 16 * 32, IT_E = 3 * IT_MAT, IT_L = NE * IT_E, IT_EXP = DEPTH * IT_L;
#define EXP_DECODE(it_, src_, dst_, k0_, n0_, drow_, sc_) do { const int L_ = (it_) / IT_L, r_ = (it_) % IT_L, e_ = r_ / IT_E, r2_ = r_ % IT_E, mat_ = r2_ / IT_MAT, r3_ = r2_ % IT_MAT, kb_ = r3_ / 32, nb_ = r3_ % 32; \
        const size_t moff_ = ((size_t)L_ * NE + e_) * (size_t)(D * D); n0_ = 32 * nb_; k0_ = 64 * kb_; \
        if (mat_ == 2) { src_ = a.in[20] + moff_; dst_ = ws + WS_WD + moff_; drow_ = n0_; sc_ = WD_SCALE; } \
        else { src_ = a.in[mat_ == 0 ? 16 : 18] + moff_; dst_ = ws + WS_WGU + 2 * moff_; drow_ = (n0_ >> 7) * 256 + ((n0_ & 127) >> 5) * 64 + (mat_ == 1 ? 32 : 0);     sc_ = WGU_SCALE; } } while (0)
    { int it = gw; TileRegs cur, nxt; const float* src; unsigned char* dst; int k0, n0, drow; float sc;
      if (it < IT_EXP) { EXP_DECODE(it, src, dst, k0, n0, drow, sc); tile_load(cur, src, D, k0, n0, F.lane); }
      while (it < IT_EXP) {
          const int itn = it + NGW; const float* srcn = src; unsigned char* dstn = dst; int k0n = k0, n0n = n0, drown = drow; float scn = sc;
          if (itn < IT_EXP) { EXP_DECODE(itn, srcn, dstn, k0n, n0n, drown, scn); tile_load(nxt, srcn, D, k0n, n0n, F.lane); }
          tile_store8(cur, D, dst, k0, drow, sc, scr, F.lane);
          cur = nxt; it = itn; src = srcn; dst = dstn; k0 = k0n; n0 = n0n; drow = drown; sc = scn;
      } }
#undef EXP_DECODE
    for (int it = gw; it < DEPTH * 16 * 96; it += NGW) {
        const int L = it / (16 * 96), r = it % (16 * 96), kb = r / 96, nb = r % 96, n0 = 32 * nb;
        const float* src = (L == 0) ? a.in[2] : (L == 1) ? a.in[5] : (L == 2) ? a.in[7] : a.in[2] + (size_t)D * 3 * D;
        const int ldw = (L == 2) ? 3 * D + NH : 3 * D;
        const int drow0 = (L == 0 || L == 3 || n0 < 2048) ? n0 : in_vrow0(L) + n0 - 2048;
        transpose_item(src, ldw, D, (bf16*)(ws + WS_WIN + (size_t)L * WIN_STRIDE), 64 * kb, n0, drow0, scr, F.lane);
    }
    for (int it = gw; it < 2 * DEPTH * IT_MAT; it += NGW) {
        const int w = it / (DEPTH * IT_MAT), r = it % (DEPTH * IT_MAT), L = r / IT_MAT, r3 = r % IT_MAT, kb = r3 / 32, nb = r3 % 32;
        const float* src; bf16* dst;
        if (w == 0) { src = (L == 0) ? a.in[4] : (L == 1) ? a.in[6] : (L == 2) ? a.in[9] : a.in[4] + (size_t)D * D; dst = (bf16*)(ws + WS_WOUT) + (size_t)L * D * D; }
        else { src = a.in[23] + (size_t)L * D * D; dst = (bf16*)(ws + WS_WPG) + (size_t)L * D * D; }
        if (w == 0) transpose_item(src, D, D, dst, 64 * kb, 32 * nb, 32 * nb, scr, F.lane);
        else { TileRegs tr; tile_load(tr, src, D, 64 * kb, 32 * nb, F.lane); tile_store8(tr, D, ws + WS_WPG + (size_t)L * D * D, 64 * kb, 32 * nb, WPG_SCALE, scr, F.lane); }
    }
    for (int it = gw; it < DEPTH * (128 + 16); it += NGW) {
        const int L = it / 144, r = it % 144;
        if (r < 128) transpose_item(a.in[22] + (size_t)L * PLE * D, D, PLE, (bf16*)(ws + WS_WPP) + (size_t)L * D * PLE, 64 * (r / 32), 32 * (r % 32), 32 * (r % 32), scr, F.lane);
        else transpose_item(a.in[14] + (size_t)L * D * NE, NE, D, (bf16*)(ws + WS_WR) + (size_t)L * 256 * D, 64 * (r - 128), 0, 0, scr, F.lane);
    }
    const size_t gt = (size_t)F.vcu * NTHR + F.tid, NGT = (size_t)F.G * NTHR;
    { bf16* win2 = (bf16*)(ws + WS_WIN + 2 * WIN_STRIDE);
      for (size_t i = gt; i < (size_t)NH * D; i += NGT) { const int c = (int)(i / D), k = (int)(i % D); win2[(size_t)(3072 + c) * D + k] = (bf16)f2bf(a.in[7][(size_t)k * (3 * D + NH) + 3 * D + c]); }
      v4u z = {0u, 0u, 0u, 0u};
      for (size_t i = gt; i < (size_t)(256 - NH) * D / 8; i += NGT) *(GAS v4u*)(win2 + (size_t)(3072 + NH) * D + i * 8) = z;
      for (size_t i = gt; i < (size_t)DEPTH * (256 - NE) * D / 8; i += NGT) { const size_t L = i / ((256 - NE) * D / 8), r = i % ((256 - NE) * D / 8);
          *(GAS v4u*)((bf16*)(ws + WS_WR) + L * 256 * D + (size_t)NE * D + r * 8) = z; } }
    { const float* x = a.in[0]; bf16* xb = (bf16*)(ws + WS_XB2);
      for (size_t i = gt; i < (size_t)T * D / 8; i += NGT) { const f32x4 v0 = *(const GAS f32x4*)(x + i * 8), v1 = *(const GAS f32x4*)(x + i * 8 + 4);
          v4u o; o.x = pk2(v0.x, v0.y); o.y = pk2(v0.z, v0.w); o.z = pk2(v1.x, v1.y); o.w = pk2(v1.z, v1.w); *(GAS v4u*)(xb + i * 8) = o; }
      const float* p = a.in[1]; bf16* pb = (bf16*)(ws + WS_PB);
      for (size_t i = gt; i < (size_t)DEPTH * T * PLE / 8; i += NGT) { const f32x4 v0 = *(const GAS f32x4*)(p + i * 8), v1 = *(const GAS f32x4*)(p + i * 8 + 4);
          v4u o; o.x = pk2(v0.x, v0.y); o.y = pk2(v0.z, v0.w); o.z = pk2(v1.x, v1.y); o.w = pk2(v1.z, v1.w); *(GAS v4u*)(pb + i * 8) = o; } }
}

__device__ __forceinline__ void ln_store(f32x4 (&v)[4], float* orow, bf16* obrow, unsigned char* o8row, const float* g, const float* b, int lane) {
    float s = 0.f;
#pragma unroll
    for (int j = 0; j < 4; ++j) s += (v[j].x + v[j].y) + (v[j].z + v[j].w);
    const float mean = wave_sum(s, lane) * (1.f / D); float s2 = 0.f;
#pragma unroll
    for (int j = 0; j < 4; ++j) { v[j] = v[j] - mean; s2 += (v[j].x * v[j].x + v[j].y * v[j].y) + (v[j].z * v[j].z + v[j].w * v[j].w); }
    const float rstd = 1.f / sqrtf(wave_sum(s2, lane) * (1.f / D) + LN_EPS);
#pragma unroll
    for (int j = 0; j < 4; ++j) { const f32x4 gg = *(const GAS f32x4*)(g + 4 * (64 * j + lane)), bb = *(const GAS f32x4*)(b + 4 * (64 * j + lane));
        const f32x4 y = v[j] * rstd * gg + bb;
        if (orow) *(GAS f32x4*)(orow + 4 * (64 * j + lane)) = y;
        v2u o; o.x = pk2(y.x, y.y); o.y = pk2(y.z, y.w); *(GAS v2u*)(obrow + 4 * (64 * j + lane)) = o;
        if (o8row) *(GAS unsigned*)(o8row + 4 * (64 * j + lane)) = pg8::pk4_fp8(y.x, y.y, y.z, y.w); }
}

__device__ __forceinline__ int crow(int r, int hi) { return (r & 3) + 8 * (r >> 2) + 4 * hi; }
__device__ __forceinline__ void sb_task(int b, int h, int qblk, const bf16* Q, const bf16* Kt, const bf16* Vt, bf16* O, int lane) {
    const int r32 = lane & 31, hi = lane >> 5;
    const int q0 = qblk * 32, tq = q0 + r32;
    const size_t rowb = (size_t)b * SEQ;
    bf16x8 qr[4];
    { const bf16* Qp = Q + (rowb + tq) * D + h * HD + hi * 8;
#pragma unroll
      for (int d0 = 0; d0 < 4; ++d0) qr[d0] = *(const GAS bf16x8*)(Qp + d0 * 16); }
    f32x16 o0, o1;
#pragma unroll
    for (int r = 0; r < 16; ++r) { o0[r] = 0.f; o1[r] = 0.f; }
    const bf16* Kb = Kt + (rowb + r32) * D + h * HD + hi * 8;
    const bf16* Vb = Vt + (size_t)(h * HD + r32) * T + rowb + 4 * hi;
    const int jmax = (q0 + 31) >> 6;
    float rrun = 0.f;
    bf16x8 kA[2][4], kB[2][4];
#pragma unroll
    for (int d0 = 0; d0 < 4; ++d0) { kA[0][d0] = *(const GAS bf16x8*)(Kb + (size_t)(64 * jmax) * D + d0 * 16); kA[1][d0] = *(const GAS bf16x8*)(Kb + (size_t)(64 * jmax + 32) * D + d0 * 16); }
    for (int j = jmax; j >= 0; --j) {
        const int s0 = 64 * j;
        if (j > 0) {
#pragma unroll
            for (int d0 = 0; d0 < 4; ++d0) { kB[0][d0] = *(const GAS bf16x8*)(Kb + (size_t)(s0 - 64) * D + d0 * 16); kB[1][d0] = *(const GAS bf16x8*)(Kb + (size_t)(s0 - 32) * D + d0 * 16); }
        }
        f32x16 p0, p1;
#pragma unroll
        for (int r = 0; r < 16; ++r) { p0[r] = 0.f; p1[r] = 0.f; }
#pragma unroll
        for (int d0 = 0; d0 < 4; ++d0) { p0 = __builtin_amdgcn_mfma_f32_32x32x16_bf16(kA[0][d0], qr[d0], p0, 0, 0, 0); p1 = __builtin_amdgcn_mfma_f32_32x32x16_bf16(kA[1][d0], qr[d0], p1, 0, 0, 0); }
        s16x4 va[2][2][2][2];
#pragma unroll
        for (int c = 0; c < 2; ++c)
#pragma unroll
            for (int m = 0; m < 2; ++m) { const bf16* vp = Vb + s0 + 32 * c + 16 * m;
                va[c][m][0][0] = *(const GAS s16x4*)(vp); va[c][m][0][1] = *(const GAS s16x4*)(vp + 8);
                va[c][m][1][0] = *(const GAS s16x4*)(vp + (size_t)32 * T); va[c][m][1][1] = *(const GAS s16x4*)(vp + (size_t)32 * T + 8); }
        const bool diag = (j == jmax);
        f32x16 s0v, s1v; float gt_[8];
#pragma unroll
        for (int r = 0; r < 16; ++r) {
            const float za = fminf(p0[r], 126.f), zb = fminf(p1[r], 126.f);
            float sa = __builtin_amdgcn_logf(1.0f + __builtin_amdgcn_exp2f(za)), sb = __builtin_amdgcn_logf(1.0f + __builtin_amdgcn_exp2f(zb));
            if (diag) { const int kv = s0 + crow(r, hi); if (kv >= tq) sa = 0.f; if (kv + 32 >= tq) sb = 0.f; }
            s0v[r] = sa; s1v[r] = sb;
        }
#pragma unroll
        for (int a4 = 0; a4 < 4; ++a4) {
            s0v[4 * a4 + 2] += s0v[4 * a4 + 3]; s0v[4 * a4 + 1] += s0v[4 * a4 + 2]; s0v[4 * a4] += s0v[4 * a4 + 1]; gt_[a4] = s0v[4 * a4];
            s1v[4 * a4 + 2] += s1v[4 * a4 + 3]; s1v[4 * a4 + 1] += s1v[4 * a4 + 2]; s1v[4 * a4] += s1v[4 * a4 + 1]; gt_[4 + a4] = s1v[4 * a4];
        }
        float run = 0.f; float offs[8];
#pragma unroll
        for (int i = 7; i >= 0; --i) {
            const float other = shfl_f(gt_[i], lane ^ 32);
            const float hi_tot = hi ? gt_[i] : other, lo_tot = hi ? other : gt_[i];
            offs[i] = hi ? run : run + hi_tot;
            run += hi_tot + lo_tot;
        }
#pragma unroll
        for (int r = 0; r < 16; ++r) {
            float w0 = __builtin_amdgcn_exp2f(p0[r] - s0v[r] - offs[r >> 2] + rrun), w1 = __builtin_amdgcn_exp2f(p1[r] - s1v[r] - offs[4 + (r >> 2)] + rrun);
            if (diag) { const int kv = s0 + crow(r, hi); if (kv >= tq) w0 = 0.f; if (kv + 32 >= tq) w1 = 0.f; }
            p0[r] = w0; p1[r] = w1;
        }
        rrun -= run;
#pragma unroll
        for (int c = 0; c < 2; ++c)
#pragma unroll
            for (int m = 0; m < 2; ++m) {
                v4u pw;
                if (c == 0) { pw.x = pg8::cvt_pk_bf16(p0[8 * m], p0[8 * m + 1]); pw.y = pg8::cvt_pk_bf16(p0[8 * m + 2], p0[8 * m + 3]); pw.z = pg8::cvt_pk_bf16(p0[8 * m + 4], p0[8 * m + 5]); pw.w = pg8::cvt_pk_bf16(p0[8 * m + 6], p0[8 * m + 7]); }
                else { pw.x = pg8::cvt_pk_bf16(p1[8 * m], p1[8 * m + 1]); pw.y = pg8::cvt_pk_bf16(p1[8 * m + 2], p1[8 * m + 3]); pw.z = pg8::cvt_pk_bf16(p1[8 * m + 4], p1[8 * m + 5]); pw.w = pg8::cvt_pk_bf16(p1[8 * m + 6], p1[8 * m + 7]); }
                const bf16x8 pf = __builtin_bit_cast(bf16x8, pw);
                const s16x4 a0 = va[c][m][0][0], a1 = va[c][m][0][1], b0 = va[c][m][1][0], b1 = va[c][m][1][1];
                const bf16x8 vf0 = (bf16x8){a0[0], a0[1], a0[2], a0[3], a1[0], a1[1], a1[2], a1[3]}, vf1 = (bf16x8){b0[0], b0[1], b0[2], b0[3], b1[0], b1[1], b1[2], b1[3]};
                o0 = __builtin_amdgcn_mfma_f32_32x32x16_bf16(vf0, pf, o0, 0, 0, 0);
                o1 = __builtin_amdgcn_mfma_f32_32x32x16_bf16(vf1, pf, o1, 0, 0, 0);
            }
        if (__all(rrun < -200.f)) break;
#pragma unroll
        for (int c = 0; c < 2; ++c)
#pragma unroll
            for (int d0 = 0; d0 < 4; ++d0) kA[c][d0] = kB[c][d0];
    }
    bf16* Op = O + (rowb + tq) * D + h * HD + 4 * hi;
#pragma unroll
    for (int a4 = 0; a4 < 4; ++a4) {
        v2u w0, w1;
        w0.x = pg8::cvt_pk_bf16(o0[4 * a4], o0[4 * a4 + 1]); w0.y = pg8::cvt_pk_bf16(o0[4 * a4 + 2], o0[4 * a4 + 3]);
        w1.x = pg8::cvt_pk_bf16(o1[4 * a4], o1[4 * a4 + 1]); w1.y = pg8::cvt_pk_bf16(o1[4 * a4 + 2], o1[4 * a4 + 3]);
        *(GAS v2u*)(Op + 8 * a4) = w0; *(GAS v2u*)(Op + 32 + 8 * a4) = w1;
    }
}
__device__ __forceinline__ void sb_phase(Frame& F, const bf16* Q, const bf16* Kt, const bf16* Vt, bf16* O) {
    const int gw = F.vcu * NWAVES + F.wave, NGW = F.G * NWAVES;
    for (int vw = gw; vw < BATCH * NH * 16; vw += NGW) {
        const int bh = vw >> 4, w16 = vw & 15;
        for (int i = 0; i < 8; ++i) { const int qblk = (i & 1) ? 16 * i + 15 - w16 : 16 * i + w16; sb_task(bh / NH, bh % NH, qblk, Q, Kt, Vt, O, F.lane); }
    }
}

namespace attn_body {
using bf16=unsigned short;
using f32x4=__attribute__((ext_vector_type(4)))float;
using bf16x8=__attribute__((ext_vector_type(8)))short;
using s16x4=__attribute__((ext_vector_type(4)))short;
using f32x16=__attribute__((ext_vector_type(16)))float;
using u32x4=__attribute__((ext_vector_type(4)))unsigned;
constexpr int BATCH=8,NHEAD=16,SEQ=4096,D=64,DM=NHEAD*D;
constexpr int NW=8,QBLK=32,QB=QBLK*NW,KVBLK=64,NQB=SEQ/QB;
constexpr int ATTN_PITCH=DM, ATTN_UNIT_ROWS=QB;
__device__ __forceinline__ int crow(int r,int hi){return (r&3)+8*(r>>2)+4*hi;}
#define SBAR() __builtin_amdgcn_sched_barrier(0)
__device__ __forceinline__ void cmask(f32x16&p0,f32x16&p1,int jb,int qrel,int hi){
  const float NEG=-INFINITY; int kb=64*jb+4*hi;
  #pragma unroll
  for(int r=0;r<16;++r){int kv=kb+(r&3)+8*(r>>2); if(kv>qrel)p0[r]=NEG; if(kv+32>qrel)p1[r]=NEG;}
}

constexpr int NSLOT=3, SLOTB=8192;
constexpr int LDS_K=0, LDS_V=NSLOT*SLOTB, LDS_WS=2*NSLOT*SLOTB, LDS_OST=LDS_WS+NW*64*4, LDS_NB=LDS_OST+NW*4096+2048, LDS_BYTES=LDS_NB+SEQ*4;
constexpr float C2=0.125f*1.4426950408889634f;
__device__ __forceinline__ void glds16(const void*gsrc,unsigned lds_dst){unsigned keep;
  asm volatile("s_mov_b32 %0, m0\n\ts_mov_b32 m0, %2\n\ts_nop 0\n\tglobal_load_lds_dwordx4 %1, off\n\ts_mov_b32 m0, %0":"=&s"(keep):"v"(gsrc),"s"(lds_dst):"memory");}
__device__ __forceinline__ float max3f(float a,float b,float c){float r;asm("v_max3_f32 %0, %1, %2, %3":"=v"(r):"v"(a),"v"(b),"v"(c));return r;}
__device__ __forceinline__ float max2f(float a,float b){float r;asm("v_max_f32_e32 %0, %1, %2":"=v"(r):"v"(a),"v"(b));return r;}
__device__ __forceinline__ float fadd_s(float a,float b){float r;asm("v_add_f32_e32 %0, %1, %2":"=v"(r):"v"(a),"v"(b));return r;}
__device__ __forceinline__ float fsub_s(float a,float b){float r;asm("v_sub_f32_e32 %0, %1, %2":"=v"(r):"v"(a),"v"(b));return r;}
typedef float f32x2_t __attribute__((ext_vector_type(2))); typedef __bf16 bf16x2_t __attribute__((ext_vector_type(2)));
__device__ __forceinline__ unsigned cvtpk_s(float lo,float hi){f32x2_t v={lo,hi};bf16x2_t b=__builtin_convertvector(v,bf16x2_t);return __builtin_bit_cast(unsigned,b);}
#define WAIT_BAR(N) asm volatile("s_waitcnt vmcnt(" #N ") lgkmcnt(0)\n\ts_barrier":::"memory")

__device__ __forceinline__ void qkt(f32x16&p0,f32x16&p1,const char*Kslot,const bf16x8*qr,const f32x16&c0i,const f32x16&c1i,int r32,int hi){
  const char*kb=Kslot+hi*1024+r32*16;
  #pragma unroll
  for(int d0=0;d0<4;++d0){
    const bf16x8 b0=*reinterpret_cast<const bf16x8*>(kb+d0*2048);
    const bf16x8 b1=*reinterpret_cast<const bf16x8*>(kb+d0*2048+512);
    if(d0==0){p0=__builtin_amdgcn_mfma_f32_32x32x16_bf16(b0,qr[0],c0i,0,0,0);p1=__builtin_amdgcn_mfma_f32_32x32x16_bf16(b1,qr[0],c1i,0,0,0);}
    else{p0=__builtin_amdgcn_mfma_f32_32x32x16_bf16(b0,qr[d0],p0,0,0,0);p1=__builtin_amdgcn_mfma_f32_32x32x16_bf16(b1,qr[d0],p1,0,0,0);}}
}
typedef __attribute__((address_space(3))) const char* lds_cptr;
typedef short v4i16_t __attribute__((ext_vector_type(4)));
__device__ __forceinline__ void kload8(bf16x8*kf,lds_cptr kp){
  kf[0]=*(const __attribute__((address_space(3))) bf16x8*)(kp);      kf[1]=*(const __attribute__((address_space(3))) bf16x8*)(kp+512);
  kf[2]=*(const __attribute__((address_space(3))) bf16x8*)(kp+2048); kf[3]=*(const __attribute__((address_space(3))) bf16x8*)(kp+2560);
  kf[4]=*(const __attribute__((address_space(3))) bf16x8*)(kp+4096); kf[5]=*(const __attribute__((address_space(3))) bf16x8*)(kp+4608);
  kf[6]=*(const __attribute__((address_space(3))) bf16x8*)(kp+6144); kf[7]=*(const __attribute__((address_space(3))) bf16x8*)(kp+6656);
}
__device__ __forceinline__ void kload2(bf16x8*kf,lds_cptr kp,int j){ kf[2*j]=*(const __attribute__((address_space(3))) bf16x8*)(kp+j*2048); kf[2*j+1]=*(const __attribute__((address_space(3))) bf16x8*)(kp+j*2048+512); }
__device__ __forceinline__ s16x4 vtr(lds_cptr p){ return __builtin_bit_cast(s16x4,__builtin_amdgcn_ds_read_tr16_b64_v4i16((__attribute__((address_space(3))) v4i16_t*)p)); }
__device__ __forceinline__ float rowmax(const f32x16&p0,const f32x16&p1){
  float a=max3f(p0[0],p0[1],p1[0]),b=max3f(p0[2],p0[3],p1[1]);a=max3f(a,p1[2],p1[3]);
  #pragma unroll
  for(int r=4;r<16;r+=4){a=max3f(a,p0[r],p0[r+1]);b=max3f(b,p0[r+2],p0[r+3]);a=max3f(a,p1[r],p1[r+1]);b=max3f(b,p1[r+2],p1[r+3]);}
  const float m=max2f(a,b);
  auto rr=__builtin_amdgcn_permlane32_swap(__float_as_uint(m),__float_as_uint(m),false,false);
  return max2f(__uint_as_float(rr[0]),__uint_as_float(rr[1]));
}
__device__ __forceinline__ void pv(f32x16*o,int vb,bf16x8 pa0,bf16x8 pa1,bf16x8 pa2,bf16x8 pa3){
  #pragma unroll
  for(int d0=0;d0<2;++d0){s16x4 lo[4],hi[4];
    #pragma unroll
    for(int ks=0;ks<4;++ks){
      asm volatile("ds_read_b64_tr_b16 %0,%1 offset:%c2":"=&v"(lo[ks]):"v"(vb),"i"(d0*4096+ks*1024):"memory");
      asm volatile("ds_read_b64_tr_b16 %0,%1 offset:%c2":"=&v"(hi[ks]):"v"(vb),"i"(d0*4096+ks*1024+512):"memory");}
    asm volatile("s_waitcnt lgkmcnt(0)":::"memory");SBAR();
    #define PK(k) (bf16x8){lo[k][0],lo[k][1],lo[k][2],lo[k][3],hi[k][0],hi[k][1],hi[k][2],hi[k][3]}
    o[d0]=__builtin_amdgcn_mfma_f32_32x32x16_bf16(pa0,PK(0),o[d0],0,0,0);
    o[d0]=__builtin_amdgcn_mfma_f32_32x32x16_bf16(pa1,PK(1),o[d0],0,0,0);
    o[d0]=__builtin_amdgcn_mfma_f32_32x32x16_bf16(pa2,PK(2),o[d0],0,0,0);
    o[d0]=__builtin_amdgcn_mfma_f32_32x32x16_bf16(pa3,PK(3),o[d0],0,0,0);
    #undef PK
  }
}

#ifndef ATTN_STORE16
#define ATTN_STORE16(p,v) (*(u32x4*)(p)=(v))
#endif
template<int THRL> __device__ __forceinline__ void attn_unit(int b,int h,int qb,const bf16*Q,const bf16*__restrict__ K,const bf16*__restrict__ V,bf16*O,char*shm,const int tid,const int t0){
  const int lane=tid&63,r32=lane&31,hi=lane>>5; const int wid=__builtin_amdgcn_readfirstlane(tid>>6);
  const long rowbase=(long)b*SEQ; const int q0=qb*QB;
  const bf16*Qw=Q+(rowbase+q0+wid*QBLK)*DM+h*D;
  const bf16*Kh=K+(rowbase+(long)t0*KVBLK)*DM+h*D,*Vh=V+(rowbase+(long)t0*KVBLK)*DM+h*D;
  const unsigned lds0=(unsigned)(uintptr_t)shm;
  float*wsf=(float*)(shm+LDS_WS)+wid*64;
  const bf16*ksrc=Kh+(long)lane*DM+wid*8;
  const bf16*vsrc=Vh+(long)(16*(wid&3)+(lane>>2))*DM+(wid>>2)*32+(lane&3)*8;
  const unsigned kdst=lds0+LDS_K+wid*1024, vdst=lds0+LDS_V+wid*1024;
  #define DMA_K(t,slot) glds16(ksrc+(long)(t)*KVBLK*DM,(unsigned)__builtin_amdgcn_readfirstlane(kdst+(slot)))
  #define DMA_V(t,slot) glds16(vsrc+(long)(t)*KVBLK*DM,(unsigned)__builtin_amdgcn_readfirstlane(vdst+(slot)))
  const int vb0=(int)(lds0+LDS_V)+((lane>>4)&1)*32+(lane&3)*8+(4*hi+((lane&15)>>2))*64;
  const char*Kbase=shm+LDS_K; bf16x8 kf[8];
  const lds_cptr shm3=(lds_cptr)shm; const lds_cptr kp0=shm3+LDS_K+hi*1024+r32*16; const lds_cptr vp0=shm3+LDS_V+((lane>>4)&1)*32+(lane&3)*8+(4*hi+((lane&15)>>2))*64;
  const int NT=(q0+QB)/KVBLK-t0;
  DMA_K(0,0);DMA_V(0,0);DMA_K(1,SLOTB);
  bf16x8 qr[4];
  #pragma unroll
  for(int d0=0;d0<4;++d0)qr[d0]=*reinterpret_cast<const bf16x8*>(&Qw[(long)r32*DM+d0*16+hi*8]);
  float mhat=0.f,l_reg=0.f;f32x16 o[2];o[0]=f32x16{};o[1]=f32x16{};float nmh=0.f;
  const int qrel=wid*QBLK+r32;
  const __attribute__((address_space(3))) float* nbt=(const __attribute__((address_space(3))) float*)(shm3+LDS_NB)+64*t0;
  #define MKCB(C0,C1,t) do{ const __attribute__((address_space(3))) float* bp_=nbt+64*(t)+4*hi; _Pragma("unroll") for(int a_=0;a_<4;++a_){ const f32x4 v0_=*(const __attribute__((address_space(3))) f32x4*)(bp_+8*a_), v1_=*(const __attribute__((address_space(3))) f32x4*)(bp_+32+8*a_); _Pragma("unroll") for(int i_=0;i_<4;++i_){ C0[4*a_+i_]=v0_[i_]+nmh; C1[4*a_+i_]=v1_[i_]+nmh; } } }while(0)
  #define CMASK(P0,P1,t) do{int jb_=(t)-(NT-4); if(jb_>=0)cmask(P0,P1,jb_,qrel,hi);}while(0)
  bool resc=false;
  #define START(P0,P1) do{ const float rm=rowmax(P0,P1); resc=false; \
    { const float dl=rm; mhat=fadd_s(mhat,dl); \
      _Pragma("unroll") for(int r=0;r<16;++r){P0[r]=fsub_s(P0[r],dl);P1[r]=fsub_s(P1[r],dl);} \
      nmh=-mhat; } \
    _Pragma("unroll") for(int r=0;r<16;++r)P0[r]=__builtin_amdgcn_exp2f(P0[r]); }while(0)
  #define RESC() do{ if(resc){ asm volatile("s_waitcnt lgkmcnt(0)":::"memory"); \
      _Pragma("unroll") for(int d_=0;d_<2;++d_) _Pragma("unroll") for(int r=0;r<16;++r)o[d_][r]*=wsf[crow(r,hi)]; } }while(0)
  f32x16 pA0,pA1,pB0,pB1;
  int sl_prev=0,sl_cur=0,sl_next=SLOTB;
  #define ROT() do{sl_prev=sl_cur;sl_cur=sl_next;sl_next=(sl_next==(NSLOT-1)*SLOTB)?0:sl_next+SLOTB;}while(0)
  DMA_K(2,2*SLOTB);
  WAIT_BAR(3);
  MKCB(pA0,pA1,0); qkt(pA0,pA1,Kbase,qr,pA0,pA1,r32,hi);asm volatile("s_nop 15\n\ts_nop 7":"+v"(pA0),"+v"(pA1));CMASK(pA0,pA1,0);
  START(pA0,pA1);
  _Pragma("unroll") for(int r=0;r<16;++r)pA1[r]=__builtin_amdgcn_exp2f(pA1[r]);
  WAIT_BAR(0);
  DMA_K(3,0);DMA_V(1,SLOTB);
  ROT();
  kload8(kf,kp0+sl_cur);
  WAIT_BAR(2);
  s16x4 vlo[8],vhi[8]; u32x4 pw0,pw1,pw2,pw3;
  #define PKW(P,B) cvtpk_s(P[B],P[B+1])
  #define PAF(k) __builtin_bit_cast(bf16x8,pw##k)
  #define VFR(i) (bf16x8){vlo[i][0],vlo[i][1],vlo[i][2],vlo[i][3],vhi[i][0],vhi[i][1],vhi[i][2],vhi[i][3]}
  #define PIN(x) asm volatile("":"+v"(x))
  #define MX3(a,b,c) __builtin_fmaxf(__builtin_fmaxf((a),(b)),(c))
  #define GAPA(MF,A0,A1,A2,A3,W0,W1,PW) do{ MF; sacc+=A0; sacc+=A1; sacc+=A2; sacc+=A3; PIN(sacc); W0; W1; PIN(PW); SBAR(); }while(0)
  #define EX(v) __builtin_amdgcn_exp2f(v)
  #define GAPB(MF,X,B) do{ MF; X[B]=EX(X[B]); X[B+1]=EX(X[B+1]); X[B+2]=EX(X[B+2]); X[B+3]=EX(X[B+3]); PIN(X); SBAR(); }while(0)
  #define VRD(i) do{ vlo[i]=vtr(vp_+(((i)>>2)*4096+((i)&3)*1024)); vhi[i]=vtr(vp_+(((i)>>2)*4096+((i)&3)*1024+512)); }while(0)
  #define KRD(G,j) do{ if(G){ kload2(kf,kp0+sl_next,j); SBAR(); } }while(0)
  #define STEP(C0,C1,P0,P1,t,GK,GV,GL) do{ SBAR(); MKCB(C0,C1,t); SBAR(); \
    const lds_cptr vp_=vp0+sl_prev; \
    VRD(0); SBAR(); float sacc=(P0[0]+P0[1]); \
    GAPA(C0=__builtin_amdgcn_mfma_f32_32x32x16_bf16(kf[0],qr[0],C0,0,0,0), P0[2],P0[3],P0[4],P0[5],     pw0[0]=PKW(P0,0), pw0[1]=PKW(P0,2), pw0); \
    VRD(4); SBAR(); GAPA(C1=__builtin_amdgcn_mfma_f32_32x32x16_bf16(kf[1],qr[0],C1,0,0,0), P0[6],P0[7],P0[8],P0[9],     pw0[2]=PKW(P0,4), pw0[3]=PKW(P0,6), pw0); \
    VRD(1); SBAR(); GAPA(C0=__builtin_amdgcn_mfma_f32_32x32x16_bf16(kf[2],qr[1],C0,0,0,0),   P0[10],P0[11],P0[12],P0[13], pw1[0]=PKW(P0,8), pw1[1]=PKW(P0,10), pw1); \
    VRD(5); SBAR(); GAPA(C1=__builtin_amdgcn_mfma_f32_32x32x16_bf16(kf[3],qr[1],C1,0,0,0),   P0[14],P0[15],P1[0],P1[1],   pw1[2]=PKW(P0,12),pw1[3]=PKW(P0,14), pw1); \
    VRD(2); SBAR(); GAPA(C0=__builtin_amdgcn_mfma_f32_32x32x16_bf16(kf[4],qr[2],C0,0,0,0),   P1[2],P1[3],P1[4],P1[5],     pw2[0]=PKW(P1,0), pw2[1]=PKW(P1,2), pw2); \
    VRD(6); SBAR(); GAPA(C1=__builtin_amdgcn_mfma_f32_32x32x16_bf16(kf[5],qr[2],C1,0,0,0),   P1[6],P1[7],P1[8],P1[9],     pw2[2]=PKW(P1,4), pw2[3]=PKW(P1,6), pw2); \
    VRD(3); SBAR(); GAPA(C0=__builtin_amdgcn_mfma_f32_32x32x16_bf16(kf[6],qr[3],C0,0,0,0),   P1[10],P1[11],P1[12],P1[13], pw3[0]=PKW(P1,8), pw3[1]=PKW(P1,10), pw3); \
    VRD(7); SBAR(); GAPA(C1=__builtin_amdgcn_mfma_f32_32x32x16_bf16(kf[7],qr[3],C1,0,0,0),   P1[14],P1[15],0.f,0.f,       pw3[2]=PKW(P1,12),pw3[3]=PKW(P1,14), pw3); \
    l_reg+=sacc; \
    if(GK){DMA_K((t)+3,sl_cur);} if(GV){DMA_V((t)+1,sl_next);} \
    CMASK(C0,C1,t); \
    { float a=MX3(C0[0],C0[1],C1[0]),b=MX3(C0[2],C0[3],C1[1]); a=MX3(a,C1[2],C1[3]); \
      _Pragma("unroll") for(int r=4;r<16;r+=4){a=MX3(a,C0[r],C0[r+1]);b=MX3(b,C0[r+2],C0[r+3]);a=MX3(a,C1[r],C1[r+1]);b=MX3(b,C1[r+2],C1[r+3]);} \
      float rm=__builtin_fmaxf(a,b); { auto rr=__builtin_amdgcn_permlane32_swap(__float_as_uint(rm),__float_as_uint(rm),false,false); rm=__builtin_fmaxf(__uint_as_float(rr[0]),__uint_as_float(rr[1])); } \
      resc=false; \
      if(__builtin_expect(__any(rm>(float)THRL),0)){ const float dl=__builtin_fmaxf(rm,0.f); mhat+=dl; \
        _Pragma("unroll") for(int r=0;r<16;++r){C0[r]-=dl;C1[r]-=dl;} \
        nmh=-mhat; \
        const float f=__builtin_amdgcn_exp2f(-dl); l_reg*=f; if(hi==0)wsf[r32]=f; resc=true; } } \
    SBAR(); \
    GAPB(o[0]=__builtin_amdgcn_mfma_f32_32x32x16_bf16(PAF(0),VFR(0),o[0],0,0,0), C0,0); \
    GAPB(o[1]=__builtin_amdgcn_mfma_f32_32x32x16_bf16(PAF(0),VFR(4),o[1],0,0,0), C0,4); \
    KRD(GL,0); GAPB(o[0]=__builtin_amdgcn_mfma_f32_32x32x16_bf16(PAF(1),VFR(1),o[0],0,0,0), C0,8); \
    KRD(GL,1); GAPB(o[1]=__builtin_amdgcn_mfma_f32_32x32x16_bf16(PAF(1),VFR(5),o[1],0,0,0), C0,12); \
    KRD(GL,2); GAPB(o[0]=__builtin_amdgcn_mfma_f32_32x32x16_bf16(PAF(2),VFR(2),o[0],0,0,0), C1,0); \
    KRD(GL,3); GAPB(o[1]=__builtin_amdgcn_mfma_f32_32x32x16_bf16(PAF(2),VFR(6),o[1],0,0,0), C1,4); \
    GAPB(o[0]=__builtin_amdgcn_mfma_f32_32x32x16_bf16(PAF(3),VFR(3),o[0],0,0,0), C1,8); \
    GAPB(o[1]=__builtin_amdgcn_mfma_f32_32x32x16_bf16(PAF(3),VFR(7),o[1],0,0,0), C1,12); \
    }while(0)
  int t=1;
  #undef CMASK
  #define CMASK(P0,P1,t) do{}while(0)
  for(;t+5<NT;t+=2){
    STEP(pB0,pB1,pA0,pA1,t,true,true,true);     WAIT_BAR(2); RESC(); ROT();
    STEP(pA0,pA1,pB0,pB1,t+1,true,true,true);   WAIT_BAR(2); RESC(); ROT();
  }
  #undef CMASK
  #define CMASK(P0,P1,t) do{int jb_=(t)-(NT-4); if(jb_>=0)cmask(P0,P1,jb_,qrel,hi);}while(0)
  #define ENDW(tt) do{ if((tt)+3<NT){WAIT_BAR(2);} else if((tt)+2<NT){WAIT_BAR(1);} else {WAIT_BAR(0);} }while(0)
  for(;t+1<NT;t+=2){
    STEP(pB0,pB1,pA0,pA1,t,(t+3<NT),(t+1<NT),(t+1<NT));       ENDW(t);   RESC(); ROT();
    STEP(pA0,pA1,pB0,pB1,t+1,(t+4<NT),(t+2<NT),(t+2<NT));     ENDW(t+1); RESC(); ROT();
  }
  STEP(pB0,pB1,pA0,pA1,NT-1,false,false,false); RESC();
  { float sacc=pB0[0]+pB0[1]; _Pragma("unroll") for(int r=2;r<16;++r)sacc+=pB0[r]; _Pragma("unroll") for(int r=0;r<16;++r)sacc+=pB1[r]; l_reg+=sacc;
    pw0=(u32x4){PKW(pB0,0),PKW(pB0,2),PKW(pB0,4),PKW(pB0,6)};pw1=(u32x4){PKW(pB0,8),PKW(pB0,10),PKW(pB0,12),PKW(pB0,14)};pw2=(u32x4){PKW(pB1,0),PKW(pB1,2),PKW(pB1,4),PKW(pB1,6)};pw3=(u32x4){PKW(pB1,8),PKW(pB1,10),PKW(pB1,12),PKW(pB1,14)};
    SBAR(); pv(o,vb0+sl_cur,PAF(0),PAF(1),PAF(2),PAF(3)); }
  #undef PKW
  #undef PAF
  #undef VFR
  #undef PIN
  #undef MX3
  #undef GAPA
  #undef GAPB
  #undef EX
  #undef VRD
  #undef KRD
  #undef STEP
  #undef ENDW
  {auto rr=__builtin_amdgcn_permlane32_swap(__float_as_uint(l_reg),__float_as_uint(l_reg),false,false);l_reg=__uint_as_float(rr[0])+__uint_as_float(rr[1]);}
  if(hi==0)wsf[32+r32]=l_reg;asm volatile("s_waitcnt lgkmcnt(0)":::"memory");
  float rli[16];
  #pragma unroll
  for(int r=0;r<16;++r)rli[r]=__builtin_amdgcn_rcpf(wsf[32+crow(r,hi)]);
  bf16*Ow=O+(rowbase+q0+wid*QBLK)*DM+h*D;
  { bf16*stg=(bf16*)(shm+LDS_OST)+wid*2048;
    #pragma unroll
    for(int r=0;r<16;++r){const int orow=crow(r,hi);
      #pragma unroll
      for(int d0=0;d0<2;++d0)stg[orow*64+d0*32+r32]=(bf16)(cvtpk_s(o[d0][r]*rli[r],0.f)&0xffffu);}
    asm volatile("s_waitcnt lgkmcnt(0)":::"memory");
    #pragma unroll
    for(int i=0;i<4;++i){const int row=i*8+(lane>>3),ch=lane&7; const u32x4 v=*(const u32x4*)(stg+row*64+ch*8); ATTN_STORE16(Ow+(long)row*DM+ch*8,v);} }
  asm volatile("s_waitcnt lgkmcnt(0)\n\ts_barrier":::"memory");
  #undef MKCB
  #undef DMA_K
  #undef DMA_V
  #undef CMASK
  #undef START
  #undef RESC
  #undef ROT
}
constexpr int ATTN_LDS_BYTES=LDS_BYTES;
struct AttnTensors { const bf16* Q; const bf16* K; const bf16* V; bf16* O; };
struct AttnUnit { int bh; int qb; };
struct FoxOrder {
  int vcu,G;
  __device__ __forceinline__ bool next(int i,AttnUnit&u)const{ const int v=vcu+(i>>3)*G; if(v>=BATCH*NHEAD*2)return false; const int ii=i&7,p=v&1; u.bh=v>>1; u.qb=(ii&1)?16-ii-p:ii+p; return true; }
};
template<int THRL=8> __device__ __forceinline__ void fox_phase(char*lds,const AttnTensors&T,const bf16*gate,const float*bfp,const FoxOrder&S,const int wave_){
  for(int v=S.vcu;v<BATCH*NHEAD*2;v+=S.G){
    int tid_=tid_of(wave_); asm volatile("":"+v"(tid_));
    const int lane_=tid_&63, wid_=__builtin_amdgcn_readfirstlane(tid_>>6);
    const int bh=v>>1, b_=bh/NHEAD, h_=bh%NHEAD; float thr;
    { const float bf_=bfp[h_];
      __attribute__((address_space(3))) float* nb=(__attribute__((address_space(3))) float*)((__attribute__((address_space(3))) char*)lds+LDS_NB);
      __attribute__((address_space(3))) float* wt=(__attribute__((address_space(3))) float*)((__attribute__((address_space(3))) char*)lds+LDS_WS);
      const bf16* gp=gate+((size_t)b_*SEQ+8*tid_)*DM+h_;
      float p[8]; float run=0.f;
      _Pragma("unroll") for(int k=0;k<8;++k){ const float z2=(__uint_as_float((unsigned)gp[(size_t)k*DM]<<16)+bf_)*1.4426950408889634f;
        run+=fminf(z2,0.f)-__builtin_amdgcn_logf(1.0f+__builtin_amdgcn_exp2f(-fabsf(z2))); p[k]=run; }
      float inc=run;
      _Pragma("unroll") for(int o=1;o<64;o<<=1){ const float vv=__int_as_float(__builtin_amdgcn_ds_bpermute((lane_-o)<<2,__float_as_int(inc))); if(lane_>=o)inc+=vv; }
      float mq=0.f,mk=0.f;
      for(int k=0;k<8;++k){ const bf16* kp=T.K+((size_t)b_*SEQ+8*tid_+k)*DM+h_*D; const bf16* qp=T.Q+((size_t)b_*SEQ+8*tid_+k)*DM+h_*D; float sq=0.f,sk=0.f;
        _Pragma("unroll") for(int c=0;c<8;++c){ const u32x4 a=*(const u32x4*)(kp+8*c), q=*(const u32x4*)(qp+8*c);
          _Pragma("unroll") for(int e=0;e<4;++e){ const float al=__uint_as_float(a[e]<<16),ah=__uint_as_float(a[e]&0xffff0000u),ql=__uint_as_float(q[e]<<16),qh=__uint_as_float(q[e]&0xffff0000u); sk+=al*al+ah*ah; sq+=ql*ql+qh*qh; } }
        mq=fmaxf(mq,sq); mk=fmaxf(mk,sk); }
      _Pragma("unroll") for(int o=1;o<64;o<<=1){ mq=fmaxf(mq,__int_as_float(__builtin_amdgcn_ds_bpermute((lane_^o)<<2,__float_as_int(mq)))); mk=fmaxf(mk,__int_as_float(__builtin_amdgcn_ds_bpermute((lane_^o)<<2,__float_as_int(mk)))); }
      if(lane_==63) wt[wid_]=inc;
      if(lane_==0){ wt[16+wid_]=mq; wt[24+wid_]=mk; }
      asm volatile("s_waitcnt lgkmcnt(0)\n\ts_barrier":::"memory");
      float base=inc-run;
      _Pragma("unroll") for(int w=0;w<7;++w) if(w<wid_) base+=wt[w];
      _Pragma("unroll") for(int k=0;k<8;++k) nb[8*tid_+k]=-(base+p[k]);
      float aq=0.f,ak=0.f; _Pragma("unroll") for(int w=0;w<8;++w){ aq=fmaxf(aq,wt[16+w]); ak=fmaxf(ak,wt[24+w]); }
      thr=__int_as_float(__builtin_amdgcn_readfirstlane(__float_as_int(152.0f+2.0f*(sqrtf(aq)*sqrtf(ak)*1.01f+0.5f))));
      asm volatile("s_waitcnt vmcnt(0) lgkmcnt(0)\n\ts_barrier":::"memory"); }
    for(int ii=0;ii<8;++ii){
      const int p_=v&1, qb=(ii&1)?16-ii-p_:ii+p_;
      int t0=0;
      { const __attribute__((address_space(3))) float* nb=(const __attribute__((address_space(3))) float*)((const __attribute__((address_space(3))) char*)lds+LDS_NB);
        const float nq=nb[qb*QB]; const int tmax=4*qb;
        while(t0+2<=tmax && nq-nb[64*(t0+2)-1]>thr) t0+=2;
        t0=__builtin_amdgcn_readfirstlane(t0); }
      attn_unit<THRL>(b_,h_,qb,T.Q,T.K,T.V,T.O,lds,tid_,t0); }
  }
}
#undef SBAR
#undef WAIT_BAR
}

__global__ void __launch_bounds__(NTHR, 2) mk_fwd(Args args) {
    extern __shared__ __attribute__((aligned(16))) unsigned char lds[];
    Frame F;
    F.lds = (LAS unsigned char*)lds;
    F.tid = threadIdx.x; F.lane = F.tid & 63; F.wave = __builtin_amdgcn_readfirstlane(F.tid >> 6);
    F.G = gridDim.x; { const int bx = blockIdx.x; F.vcu = (F.G % 8 == 0) ? (bx % 8) * (F.G / 8) + bx / 8 : bx; }
    F.ws = args.ws; unsigned char* ws = args.ws;
    F.ctl = (gu32*)(ws + WS_CTL);
    volatile LAS unsigned* MISC = (volatile LAS unsigned*)(F.lds + MISC_OFF);
    for (int u = F.tid; u < (LDS_BYTES - LDSCTL_OFF) / 4; u += NTHR) ((LAS unsigned*)(F.lds + LDSCTL_OFF))[u] = 0u;
    __syncthreads();
    const int lo = args.ph_lo, hi = args.ph_hi;
    XcdBarrier bar; bar.bar = (unsigned*)(F.ctl + CW_BAR); bar.x = 0; bar.st = nullptr; bar.t0 = 0;
    if (hi - lo > 1) bar = xcd_barrier_post((unsigned*)(F.ctl + CW_BAR), MISC + 8, F.tid == 0);
#define FRESH() do { int t_ = tid_of(F.wave); asm volatile("" : "+v"(t_)); F.tid = t_; F.lane = t_ & 63; unsigned char* w_ = args.ws; asm volatile("" : "+s"(w_)); ws = w_; F.ws = w_; } while (0)
#define IN(k) (lo <= (k) && (k) < hi)
#define SEAM(k) do { if (IN(k) && IN((k) + 1)) xcd_barrier(bar, F.wave == 0 && lane_id_() == 0); } while (0)
    const int gw = F.vcu * NWAVES + F.wave, NGW = F.G * NWAVES;
    LAS int* tend = (LAS int*)(F.lds + TEND_OFF); LAS int* tbase = tend + 32;

#define XB ((bf16*)(ws + WS_XB))
#define XB2 ((bf16*)(ws + WS_XB2))
#define PP ((bf16*)(ws + WS_PP))
#define R0 ((bf16*)(ws + WS_PROJ))
#define R1 ((bf16*)(ws + WS_PROJ + PROJ_REGION))
#define R2 ((bf16*)(ws + WS_PROJ + 2 * PROJ_REGION))
#define R3 ((bf16*)(ws + WS_PROJ + 3 * PROJ_REGION))
#define HB ((bf16*)(ws + WS_H))
#define YB ((bf16*)(ws + WS_Y))
#define LOGITS ((float*)(ws + WS_LOGITS))
#define TOKE ((int*)(ws + WS_TOKE))
#define TOKG ((float*)(ws + WS_TOKG))
#define TOKLP ((int*)(ws + WS_TOKLP))
#define TOKPOS ((int*)(ws + WS_TOKPOS))
#define ROWGATE ((float*)(ws + WS_ROWGATE))
#define WGOFF ((int*)(ws + WS_WGOFF))
#define CUM ((float*)(ws + WS_CUM))
#define XF8 (ws + WS_XF8)
#define ROWTOK ((int*)(ws + WS_ROWTOK))
#define Y8 (ws + WS_Y)
#define H8 (ws + WS_H)

    if (IN(0)) { FRESH(); p0_prologue(F, args); }
    SEAM(0);

    for (int L = 0; L < DEPTH; ++L) {
        const int kind = (L == 3) ? 0 : L;
        const int P = 1 + 12 * L;
#define gcnt ((gu32*)(ws + WS_CTL) + CW_CNT + 32 * 64 * L)

        if (IN(P + 0)) { FRESH();
            const int npass = (kind == 1) ? 3 : 2;
            for (int pass = 0; pass < npass; ++pass) {
                pg8::Gemm g; pg8::EpiBf16 E; pg8::StaticOrder S; int Mg, Ng;
                if (pass == 0) {
                    Mg = T; Ng = (kind == 0) ? 3 * D : (kind == 1 ? 2 * D : 3 * D + 256);
                    g = pg8::Gemm{XB2, (const bf16*)(ws + WS_WIN + (size_t)L * WIN_STRIDE), D, 0}; E = pg8::EpiBf16{R0, D, D, PROJ_REGION / 2, (kind == 0) ? 1.0f : C2};
                } else if (pass == 1) {
                    Mg = T; Ng = D;
                    g = pg8::Gemm{(const bf16*)(ws + WS_PB) + (size_t)L * T * PLE, (const bf16*)(ws + WS_WPP) + (size_t)L * D * PLE, PLE, 0}; E = pg8::EpiBf16{PP, D, 0, 0, 1.0f};
                } else {
                    Mg = D; Ng = T;
                    g = pg8::Gemm{(const bf16*)(ws + WS_WIN + (size_t)L * WIN_STRIDE) + (size_t)in_vrow0(L) * D, XB2, D, 0}; E = pg8::EpiBf16{R3, T, 0, 0, 1.0f};
                }
                S.init(Mg, Ng, F.G, (int)blockIdx.x);
                pg8::gemm_phase<pg8::EpiBf16, pg8::StaticOrder, true>(F.lds + RING_OFF, g, S, E, F.wave);
            }
        }
        SEAM(P + 0);


        if (IN(P + 2)) { {
            if (kind == 0) { FRESH();
                const float* cw = args.in[3] + (size_t)(L == 3 ? 1 : 0) * 3 * D;
                const int cg = F.tid & 127, rg = F.tid >> 7, ch = cg * 8;
                float w0[8], w1[8], w2[8];
#pragma unroll
                for (int i = 0; i < 8; ++i) { w0[i] = cw[ch + i]; w1[i] = cw[D + ch + i]; w2[i] = cw[2 * D + ch + i]; }
                for (int blk = F.vcu; blk < T / 64; blk += F.G) {
                    const int t0 = blk * 64 + rg * 16;
                    float u1[8], u2[8];
                    if ((t0 & (SEQ - 1)) == 0) {
#pragma unroll
                        for (int i = 0; i < 8; ++i) { u1[i] = 0.f; u2[i] = 0.f; }
                    } else {
                        const v4u c1 = *(const GAS v4u*)(R1 + (size_t)(t0 - 1) * D + ch), h1 = *(const GAS v4u*)(R2 + (size_t)(t0 - 1) * D + ch);
                        const v4u c2 = *(const GAS v4u*)(R1 + (size_t)(t0 - 2) * D + ch), h2 = *(const GAS v4u*)(R2 + (size_t)(t0 - 2) * D + ch);
#pragma unroll
                        for (int i = 0; i < 4; ++i) { u1[2 * i] = bflo(c1[i]) * bflo(h1[i]); u1[2 * i + 1] = bfhi(c1[i]) * bfhi(h1[i]); u2[2 * i] = bflo(c2[i]) * bflo(h2[i]); u2[2 * i + 1] = bfhi(c2[i]) * bfhi(h2[i]); }
                    }
                    for (int r = 0; r < 16; ++r) {
                        const size_t off = (size_t)(t0 + r) * D + ch;
                        const v4u bv = *(const GAS v4u*)(R0 + off), cv = *(const GAS v4u*)(R1 + off), hv = *(const GAS v4u*)(R2 + off);
                        float u0[8], o[8];
#pragma unroll
                        for (int i = 0; i < 4; ++i) { u0[2 * i] = bflo(cv[i]) * bflo(hv[i]); u0[2 * i + 1] = bfhi(cv[i]) * bfhi(hv[i]); }
#pragma unroll
                        for (int i = 0; i < 4; ++i) {
                            o[2 * i] = bflo(bv[i]) * (w0[2 * i] * u2[2 * i] + w1[2 * i] * u1[2 * i] + w2[2 * i] * u0[2 * i]);
                            o[2 * i + 1] = bfhi(bv[i]) * (w0[2 * i + 1] * u2[2 * i + 1] + w1[2 * i + 1] * u1[2 * i + 1] + w2[2 * i + 1] * u0[2 * i + 1]); }
                        v4u ov; ov.x = pk2(o[0], o[1]); ov.y = pk2(o[2], o[3]); ov.z = pk2(o[4], o[5]); ov.w = pk2(o[6], o[7]);
                        *(GAS v4u*)(XB + off) = ov;
#pragma unroll
                        for (int i = 0; i < 8; ++i) { u2[i] = u1[i]; u1[i] = u0[i]; }
                    }
                }
            } else if (kind == 1) { FRESH();
                sb_phase(F, R0, R1, R3, XB);
            } else {
                const attn_body::AttnTensors AT{R0, R1, R2, XB}; const attn_body::FoxOrder FO{F.vcu, F.G};
                attn_body::fox_phase<32>((char*)lds + RING_OFF, AT, R3, args.in[8], FO, F.wave);
            }
        } }
        SEAM(P + 2);

        if (IN(P + 3)) { FRESH();
            pg8::Gemm g{XB, (const bf16*)(ws + WS_WOUT) + (size_t)L * D * D, D, 0}; pg8::StaticOrder S; S.init(T, D, F.G, (int)blockIdx.x);
            pg8::EpiResBf16 E{XB2, R0, D, DN_ALPHA};
            pg8::gemm_phase<pg8::EpiResBf16, pg8::StaticOrder, true>(F.lds + RING_OFF, g, S, E, F.wave);
        }
        SEAM(P + 3);

        if (IN(P + 4)) { FRESH();
            const float* g1 = args.in[10] + (size_t)L * D; const float* b1 = args.in[11] + (size_t)L * D;
            for (int m = gw; m < T; m += 4 * NGW) { v2u yy[4][4];
#pragma unroll
                for (int q = 0; q < 4; ++q)
#pragma unroll
                    for (int j = 0; j < 4; ++j) yy[q][j] = *(const GAS v2u*)(R0 + (size_t)(m + q * NGW) * D + 4 * (64 * j + F.lane));
#pragma unroll
                for (int q = 0; q < 4; ++q) { f32x4 v[4];
#pragma unroll
                    for (int j = 0; j < 4; ++j) v[j] = (f32x4){bflo(yy[q][j].x), bfhi(yy[q][j].x), bflo(yy[q][j].y), bfhi(yy[q][j].y)};
                    ln_store(v, nullptr, XB + (size_t)(m + q * NGW) * D, XF8 + (size_t)(m + q * NGW) * D, g1, b1, F.lane); } }
        }
        SEAM(P + 4);

        if (IN(P + 5)) { FRESH();
            LAS float* part = (LAS float*)(F.lds + RING_OFF);
            LAS int* hist = (LAS int*)(F.lds + RING_OFF + 2 * 128 * 33 * 4);
            const float* rb = args.in[15] + (size_t)L * NE;
            const int rbk = F.wave & 3, kh = F.wave >> 2, r32 = F.lane & 31, hi = F.lane >> 5;
            for (int tb = F.vcu; tb < T / 128; tb += F.G) {
                if (F.tid < 32) hist[F.tid] = 0;
                {
                  const bf16* ap = (const bf16*)(ws + WS_WR) + (size_t)L * 256 * D + (size_t)r32 * D + 512 * kh + 8 * hi;
                  const bf16* bp = XB + (size_t)(tb * 128 + 32 * rbk + r32) * D + 512 * kh + 8 * hi;
                  f32x16 acc;
#pragma unroll
                  for (int r = 0; r < 16; ++r) acc[r] = 0.f;
#pragma unroll 8
                  for (int kk = 0; kk < 32; ++kk) { const bf16x8 a_ = *(const GAS bf16x8*)(ap + 16 * kk), b_ = *(const GAS bf16x8*)(bp + 16 * kk); acc = __builtin_amdgcn_mfma_f32_32x32x16_bf16(a_, b_, acc, 0, 0, 0); }
#pragma unroll
                  for (int r = 0; r < 16; ++r) part[(kh * 128 + 32 * rbk + r32) * 33 + crow(r, hi)] = acc[r]; }
                __syncthreads();
                if (F.tid < 128) {
                    const int t = tb * 128 + F.tid; float v[32];
#pragma unroll
                    for (int j = 0; j < 32; ++j) v[j] = part[F.tid * 33 + j] + part[(128 + F.tid) * 33 + j] + rb[j];
                    int ek[4]; float vk[4];
#pragma unroll
                    for (int k = 0; k < 4; ++k) { float best = v[0]; int bi = 0;
#pragma unroll
                        for (int j = 1; j < 32; ++j) if (v[j] > best) { best = v[j]; bi = j; }
#pragma unroll
                        for (int j = 0; j < 32; ++j) if (j == bi) v[j] = -INFINITY;
                        ek[k] = bi; vk[k] = best; }
                    float ex[4], se = 0.f;
#pragma unroll
                    for (int k = 0; k < 4; ++k) { ex[k] = expf(vk[k] - vk[0]); se += ex[k]; }
                    const float inv = 1.0f / se;
#pragma unroll
                    for (int k = 0; k < 4; ++k) { const int lp = __hip_atomic_fetch_add(hist + ek[k], 1, __ATOMIC_RELAXED, __HIP_MEMORY_SCOPE_WORKGROUP);
                        TOKE[t * 4 + k] = ek[k]; TOKG[t * 4 + k] = ex[k] * inv; TOKLP[t * 4 + k] = lp; }
                }
                __syncthreads();
                if (F.tid < 32) { const int c = hist[F.tid]; const unsigned off = __hip_atomic_fetch_add(gcnt + 64 * F.tid, (unsigned)c, RLX_AGENT); WGOFF[tb * 32 + F.tid] = (int)off; }
                __syncthreads();
            }
        }
        SEAM(P + 5);

        const bool need_tab = IN(P + 7) || IN(P + 8) || IN(P + 9);
        if (need_tab) { FRESH();
            if (F.tid < 64) { const int c = (F.lane < 32) ? (int)__hip_atomic_load(gcnt + 64 * (F.lane & 31), RLX_AGENT) : 0; const int tl = (c + 255) >> 8; int inc = tl;
#pragma unroll
                for (int o = 1; o < 32; o <<= 1) { const int v = shfl_i(inc, F.lane - o); if (F.lane >= o) inc += v; }
                if (F.lane < 32) { tend[F.lane] = inc; tbase[F.lane] = (inc - tl) * 256; } }
            __syncthreads();
        }
        if (IN(P + 7)) { { FRESH();
            for (int tb = F.vcu; tb < T / 128; tb += F.G) {
                { const int t = tb * 128 + (F.tid >> 2), k = F.tid & 3; const int e = TOKE[t * 4 + k];
                  const int row = tbase[e] + WGOFF[tb * 32 + e] + TOKLP[t * 4 + k];
                  ROWGATE[row] = TOKG[t * 4 + k]; TOKPOS[t * 4 + k] = row; ROWTOK[row] = t; }
                if (tb < NE) {
                    const int c = (int)__hip_atomic_load(gcnt + 64 * tb, RLX_AGENT), r0 = tbase[tb] + c, r1 = tbase[tb] + ((c + 255) & ~255);
                    for (int r = r0 + F.tid; r < r1; r += NTHR) ROWTOK[r] = 0; }
            }
        } }
        SEAM(P + 7);

        if (IN(P + 8)) { {
            pg8::Gemm g{(const bf16*)XF8, (const bf16*)(ws + WS_WGU + (size_t)L * NE * 2 * D * D), D, (size_t)2 * D * D, ROWTOK}; FRESH(); pg8::MoeOrder S; S.init(tend[31], 2 * D, F.G, (int)blockIdx.x, tend + (F.lane & 31));
            pg8::EpiSwiglu E{H8, args.in[17] + (size_t)L * NE * D, args.in[19] + (size_t)L * NE * D, 1.0f / WGU_SCALE};
            pg8::gemm_phase<pg8::EpiSwiglu, pg8::MoeOrder, true, true, true>(F.lds + RING_OFF, g, S, E, F.wave);
        } }
        SEAM(P + 8);

        if (IN(P + 9)) { {
            pg8::Gemm g{(const bf16*)H8, (const bf16*)(ws + WS_WD + (size_t)L * NE * D * D), D, (size_t)D * D}; FRESH(); pg8::MoeOrder S; S.init(tend[31], D, F.G, (int)blockIdx.x, tend + (F.lane & 31));
            pg8::EpiDown E{Y8, args.in[21] + (size_t)L * NE * D, ROWGATE, 1.0f / WD_SCALE, Y_SCALE};
            pg8::gemm_phase<pg8::EpiDown, pg8::MoeOrder, true, true>(F.lds + RING_OFF, g, S, E, F.wave);
        } }
        SEAM(P + 9);

        if (IN(P + 10)) { FRESH();
            const float* g2 = args.in[12] + (size_t)L * D; const float* b2 = args.in[13] + (size_t)L * D;
            for (int m = gw; m < T; m += 2 * NGW) { const int m2 = m + NGW; f32x4 v[4], w[4];
                int pos[4], pos2[4];
#pragma unroll
                for (int k = 0; k < 4; ++k) { pos[k] = TOKPOS[m * 4 + k]; pos2[k] = TOKPOS[m2 * 4 + k]; }
                v2u xa[4], xb_[4]; unsigned ya[4][4], yb[4][4];
#pragma unroll
                for (int j = 0; j < 4; ++j) { xa[j] = *(const GAS v2u*)(XB + (size_t)m * D + 4 * (64 * j + F.lane)); xb_[j] = *(const GAS v2u*)(XB + (size_t)m2 * D + 4 * (64 * j + F.lane));
#pragma unroll
                    for (int k = 0; k < 4; ++k) { ya[j][k] = *(const GAS unsigned*)(Y8 + (size_t)pos[k] * D + 4 * (64 * j + F.lane)); yb[j][k] = *(const GAS unsigned*)(Y8 + (size_t)pos2[k] * D + 4 * (64 * j + F.lane)); } }
#pragma unroll
                for (int j = 0; j < 4; ++j) { v[j] = (f32x4){bflo(xa[j].x), bfhi(xa[j].x), bflo(xa[j].y), bfhi(xa[j].y)} * DN_ALPHA; w[j] = (f32x4){bflo(xb_[j].x), bfhi(xb_[j].x), bflo(xb_[j].y), bfhi(xb_[j].y)} * DN_ALPHA;
#pragma unroll
                    for (int k = 0; k < 4; ++k) { const f32x2_ a0 = __builtin_amdgcn_cvt_pk_f32_fp8((int)ya[j][k], false), a1 = __builtin_amdgcn_cvt_pk_f32_fp8((int)ya[j][k], true), c0 = __builtin_amdgcn_cvt_pk_f32_fp8((int)yb[j][k], false), c1 = __builtin_amdgcn_cvt_pk_f32_fp8((int)yb[j][k], true);
                        v[j].x += a0[0] * (1.0f / Y_SCALE); v[j].y += a0[1] * (1.0f / Y_SCALE); v[j].z += a1[0] * (1.0f / Y_SCALE); v[j].w += a1[1] * (1.0f / Y_SCALE);
                        w[j].x += c0[0] * (1.0f / Y_SCALE); w[j].y += c0[1] * (1.0f / Y_SCALE); w[j].z += c1[0] * (1.0f / Y_SCALE); w[j].w += c1[1] * (1.0f / Y_SCALE); } }
                ln_store(v, nullptr, XB + (size_t)m * D, XF8 + (size_t)m * D, g2, b2, F.lane);
                ln_store(w, nullptr, XB + (size_t)m2 * D, XF8 + (size_t)m2 * D, g2, b2, F.lane); }
        }
        SEAM(P + 10);

        if (IN(P + 11)) { FRESH();
            pg8::Gemm g{(const bf16*)XF8, (const bf16*)(ws + WS_WPG + (size_t)L * D * D), D, 0}; pg8::StaticOrder S; S.init(T, D, F.G, (int)blockIdx.x);
            pg8::EpiPle E{XB, (L == DEPTH - 1) ? args.out : nullptr, XB2, PP, args.in[24] + (size_t)L * D, 1.0f / WPG_SCALE};
            pg8::gemm_phase<pg8::EpiPle, pg8::StaticOrder, true, true>(F.lds + RING_OFF, g, S, E, F.wave);
        }
        SEAM(P + 11);
    }
#undef IN
#undef SEAM
#undef gcnt
}

extern "C" void kernel_launch(void* const* d_in, const int* in_sizes, int n_in, void* d_out, int out_size, void* d_ws, size_t ws_size, hipStream_t stream) {
    static int grid = 0;
    if (grid == 0) {
        if (n_in != 25 || in_sizes[0] != T * D || out_size != T * D || ws_size < WS_END) { fprintf(stderr, "kernel_launch: unexpected shapes (n_in %d, in0 %d, out %d, ws %zu < %zu); nothing launched\n", n_in, n_in > 0 ? in_sizes[0] : -1, out_size, ws_size, (size_t)WS_END); grid = -1; return; }
        int dev = 0, cus = 0, per_cu = 0;
        if (hipGetDevice(&dev) != hipSuccess || hipDeviceGetAttribute(&cus, hipDeviceAttributeMultiprocessorCount, dev) != hipSuccess) { grid = -1; return; }
        if (hipFuncSetAttribute((const void*)mk_fwd, hipFuncAttributeMaxDynamicSharedMemorySize, LDS_BYTES) != hipSuccess) { fprintf(stderr, "kernel_launch: hipFuncSetAttribute failed\n"); grid = -1; return; }
        if (hipOccupancyMaxActiveBlocksPerMultiprocessor(&per_cu, (const void*)mk_fwd, NTHR, LDS_BYTES) != hipSuccess || per_cu < 1) fprintf(stderr, "kernel_launch: occupancy query reports %d\n", per_cu);
        (void)hipGetLastError();
        grid = cus;
    }
    if (grid < 0) return;
    if (hipMemsetAsync((char*)d_ws + WS_CTL, 0, CTL_ZERO_BYTES, stream) != hipSuccess) { fprintf(stderr, "kernel_launch: memset failed\n"); return; }
    Args a{};
    for (int i = 0; i < 25; ++i) a.in[i] = (const float*)d_in[i];
    a.out = (float*)d_out; a.ws = (unsigned char*)d_ws;
#if MK_PER_PHASE
    for (int ph = 0; ph < NPH; ++ph) { a.ph_lo = ph; a.ph_hi = ph + 1; hipLaunchKernelGGL(mk_fwd, dim3(grid), dim3(NTHR), LDS_BYTES, stream, a); }
#else
    a.ph_lo = 0; a.ph_hi = NPH;
    hipLaunchKernelGGL(mk_fwd, dim3(grid), dim3(NTHR), LDS_BYTES, stream, a);
#endif
    const hipError_t le = hipPeekAtLastError();
    if (le != hipSuccess) fprintf(stderr, "kernel_launch: launch failed: %s\n", hipGetErrorName(le));
}
```

```cpp
#include <hip/hip_runtime.h>
#include <cstdio>
#include <cstdint>

#ifndef MK_PER_PHASE
#define MK_PER_PHASE 0
#endif

__device__ __forceinline__ int lane_id_() { int l; asm volatile("v_mbcnt_lo_u32_b32 %0, -1, 0\n\tv_mbcnt_hi_u32_b32 %0, -1, %0" : "=v"(l)); return l; }
__device__ __forceinline__ int tid_of(int wave) { return wave * 64 + lane_id_(); }

namespace pg8 {
#define PG8_LAS __attribute__((address_space(3)))
typedef unsigned short bf16_t;
typedef short bf16x8 __attribute__((ext_vector_type(8)));
typedef float f32x4 __attribute__((ext_vector_type(4)));
typedef float f32x2 __attribute__((ext_vector_type(2)));
typedef unsigned u32x4 __attribute__((ext_vector_type(4)));
typedef unsigned u32x2 __attribute__((ext_vector_type(2)));
typedef int i32x4 __attribute__((ext_vector_type(4)));
typedef int i32x8 __attribute__((ext_vector_type(8)));
constexpr int BM = 256, BK = 64, HALF = 128, HTB = HALF * BK * 2  , STAGE_BYTES = 8 * HTB, NXCD = 8, WGM = 8;

__host__ __device__ __forceinline__ int lds_byte(int r, int c) { const int st = (r >> 4) * 2 + (c >> 5), rr = r & 15, cc = c & 31, ob = rr * 64 + cc * 2; return st * 1024 + (ob ^ (((ob >> 9) & 1) << 5)); }
__host__ __device__ __forceinline__ void stage_rc(int b, int& R, int& C) { const int st = b / 1024, sb = b % 1024, swz = sb ^ (((sb >> 9) & 1) << 5); R = (st >> 1) * 16 + swz / 64; C = (st & 1) * 32 + (swz % 64) / 2; }
__host__ __device__ __forceinline__ int perm32(int rho) { const int n = rho >> 4, i = rho & 15; return 8 * (i >> 2) + 4 * n + (i & 3); }

struct Unit { int pm, pn, e; };
struct Gemm { const bf16_t* A; const bf16_t* Bt; int K; size_t bstride; const int* rowtok; };

struct StaticOrder {
    int nM, nN, nwg, G, c;
    __device__ __forceinline__ void init(int M, int N, int G_, int c_) { nM = M / BM; nN = N / BM; nwg = nM * nN; G = G_; c = c_; }
    __device__ __forceinline__ bool map(int i, Unit& u) const {
        const long L = (long)i * G + c; if (L >= nwg) return false;
        int wgid = (int)L; { const int q = nwg / NXCD, r = nwg % NXCD, xcd = wgid % NXCD, off = wgid / NXCD; wgid = (xcd < r ? xcd * (q + 1) : r * (q + 1) + (xcd - r) * q) + off; }
        const int nig = WGM * nN, gid = wgid / nig, fm = gid * WGM, gsz = (nM - fm) < WGM ? (nM - fm) : WGM;
        u.pm = fm + ((wgid % nig) % gsz); u.pn = (wgid % nig) / gsz; return true;
    }
    __device__ __forceinline__ bool next(int i, Unit& u) const { u.e = 0; return map(i, u); }
};
struct MoeOrder {
    StaticOrder so; const PG8_LAS int* tend;
    __device__ __forceinline__ void init(int ntiles, int N, int G_, int c_, const PG8_LAS int* tend_lane) { so.nM = ntiles; so.nN = N / BM; so.nwg = so.nM * so.nN; so.G = G_; so.c = c_; tend = tend_lane; }
    __device__ __forceinline__ bool next(int i, Unit& u) const {
        if (!so.map(i, u)) return false;
        const int te = tend[0];
        const unsigned long long bal = __ballot(te <= u.pm);
        u.e = __builtin_popcount((unsigned)(bal & 0xffffffffull)); if (u.e > 31) u.e = 31;
        return true;
    }
};

__device__ __forceinline__ unsigned cvt_pk_bf16(float lo, float hi) { unsigned r; asm volatile("v_cvt_pk_bf16_f32 %0, %1, %2" : "=v"(r) : "v"(lo), "v"(hi)); return r; }
__device__ __forceinline__ float bf_lo(unsigned w) { return __uint_as_float(w << 16); }
__device__ __forceinline__ float bf_hi(unsigned w) { return __uint_as_float(w & 0xffff0000u); }
__device__ __forceinline__ float sigmoidf_fast(float v) { return __builtin_amdgcn_rcpf(1.0f + __builtin_amdgcn_exp2f(-1.4426950408889634f * v)); }

struct EpiBf16 {
    static constexpr bool PERM = true;
    bf16_t* O; int ldc; int split_cols; size_t split_stride; float scale0;
    __device__ __forceinline__ void operator()(const f32x4 (&acc)[2][2][4][2], const Unit& u, int wr, int wc, int fr, int fq) const {
        const int row0 = u.pm * BM + wr * 64 + fr; int colt = u.pn * BM; bf16_t* base = O;
        float sc = 1.f; if (split_cols) { const int t = colt / split_cols; base += (size_t)t * split_stride; colt -= t * split_cols; if (t == 0) sc = scale0; }
        const int col0 = colt + wc * 64 + 8 * fq;
#pragma unroll
        for (int ai = 0; ai < 2; ++ai)
#pragma unroll
            for (int m = 0; m < 4; ++m) { bf16_t* rowp = base + (size_t)(row0 + ai * HALF + m * 16) * ldc + col0;
#pragma unroll
                for (int bj = 0; bj < 2; ++bj) { f32x4 v0 = acc[ai][bj][m][0] * sc, v1 = acc[ai][bj][m][1] * sc;
                    u32x4 w; w.x = cvt_pk_bf16(v0[0], v0[1]); w.y = cvt_pk_bf16(v0[2], v0[3]); w.z = cvt_pk_bf16(v1[0], v1[1]); w.w = cvt_pk_bf16(v1[2], v1[3]);
                    *(u32x4*)(rowp + bj * 32) = w; } }
    }
};
struct EpiResBf16 {
    static constexpr bool PERM = true;
    const bf16_t* res; bf16_t* out; int ldc; float alpha;
    __device__ __forceinline__ void operator()(const f32x4 (&acc)[2][2][4][2], const Unit& u, int wr, int wc, int fr, int fq) const {
        const int row0 = u.pm * BM + wr * 64 + fr, col0 = u.pn * BM + wc * 64 + 8 * fq;
#pragma unroll
        for (int ai = 0; ai < 2; ++ai)
#pragma unroll
            for (int m = 0; m < 4; ++m) { const size_t off = (size_t)(row0 + ai * HALF + m * 16) * ldc + col0;
#pragma unroll
                for (int bj = 0; bj < 2; ++bj) { const u32x4 r = *(const u32x4*)(res + off + bj * 32); const f32x4 a0 = acc[ai][bj][m][0], a1 = acc[ai][bj][m][1];
                    u32x4 w; w.x = cvt_pk_bf16(bf_lo(r.x) * alpha + a0[0], bf_hi(r.x) * alpha + a0[1]); w.y = cvt_pk_bf16(bf_lo(r.y) * alpha + a0[2], bf_hi(r.y) * alpha + a0[3]);
                    w.z = cvt_pk_bf16(bf_lo(r.z) * alpha + a1[0], bf_hi(r.z) * alpha + a1[1]); w.w = cvt_pk_bf16(bf_lo(r.w) * alpha + a1[2], bf_hi(r.w) * alpha + a1[3]);
                    *(u32x4*)(out + off + bj * 32) = w; }
                asm volatile("" ::: "memory"); }
    }
};
struct EpiRouter {
    static constexpr bool PERM = false;
    float* out;
    __device__ __forceinline__ void operator()(const f32x4 (&acc)[2][2][4][2], const Unit& u, int wr, int wc, int fr, int fq) const {
        if (wc != 0 || u.pn != 0) return;
        const int row0 = u.pm * BM + wr * 64 + fr;
#pragma unroll
        for (int ai = 0; ai < 2; ++ai)
#pragma unroll
            for (int m = 0; m < 4; ++m) { float* rowp = out + (size_t)(row0 + ai * HALF + m * 16) * 32 + 4 * fq;
                *(f32x4*)(rowp) = acc[ai][0][m][0]; *(f32x4*)(rowp + 16) = acc[ai][0][m][1]; }
    }
};
__device__ __forceinline__ unsigned pk4_fp8(float a, float b, float c, float d) { int w = 0; w = __builtin_amdgcn_cvt_pk_fp8_f32(a, b, w, false); w = __builtin_amdgcn_cvt_pk_fp8_f32(c, d, w, true); return (unsigned)w; }
struct EpiSwiglu {
    static constexpr bool PERM = true;
    unsigned char* H; const float* bg; const float* bu; float inv_scale;
    static __device__ __forceinline__ f32x2 sw2(f32x2 accg, f32x2 accu, f32x2 gb, f32x2 ub1, float inv) {
        f32x2 g = accg * inv + gb, u = accu * inv + ub1;
        g.x = fminf(g.x, 7.0f); g.y = fminf(g.y, 7.0f);
        u.x = __builtin_amdgcn_fmed3f(u.x, -6.0f, 8.0f); u.y = __builtin_amdgcn_fmed3f(u.y, -6.0f, 8.0f);
        const f32x2 t = g * (-1.702f * 1.4426950408889634f);
        f32x2 e; e.x = __builtin_amdgcn_exp2f(t.x); e.y = __builtin_amdgcn_exp2f(t.y);
        const f32x2 d = e + 1.0f;
        f32x2 r; r.x = __builtin_amdgcn_rcpf(d.x); r.y = __builtin_amdgcn_rcpf(d.y);
        return (g * r) * u;
    }
    __device__ __forceinline__ void operator()(const f32x4 (&acc)[2][2][4][2], const Unit& u, int wr, int wc, int fr, int fq) const {
        const int row0 = u.pm * BM + wr * 64 + fr, ch0 = u.pn * HALF + wc * 32 + 8 * fq;
        f32x4 gb[2], ub[2];
#pragma unroll
        for (int n = 0; n < 2; ++n) { gb[n] = *(const f32x4*)(bg + (size_t)u.e * 1024 + ch0 + 4 * n); ub[n] = *(const f32x4*)(bu + (size_t)u.e * 1024 + ch0 + 4 * n) + 1.0f; }
#pragma unroll
        for (int ai = 0; ai < 2; ++ai)
#pragma unroll
            for (int m = 0; m < 4; ++m) { unsigned char* rowp = H + (size_t)(row0 + ai * HALF + m * 16) * 1024 + ch0; f32x2 a[4];
#pragma unroll
                for (int n = 0; n < 2; ++n) { const f32x4 ag = acc[ai][0][m][n], au = acc[ai][1][m][n];
                    a[2 * n] = sw2((f32x2){ag[0], ag[1]}, (f32x2){au[0], au[1]}, (f32x2){gb[n][0], gb[n][1]}, (f32x2){ub[n][0], ub[n][1]}, inv_scale);
                    a[2 * n + 1] = sw2((f32x2){ag[2], ag[3]}, (f32x2){au[2], au[3]}, (f32x2){gb[n][2], gb[n][3]}, (f32x2){ub[n][2], ub[n][3]}, inv_scale); }
                u32x2 w; w.x = pk4_fp8(a[0].x, a[0].y, a[1].x, a[1].y); w.y = pk4_fp8(a[2].x, a[2].y, a[3].x, a[3].y);
                *(u32x2*)rowp = w; }
    }
};
struct EpiDown {
    static constexpr bool PERM = true;
    unsigned char* Y; const float* bd; const float* rgate; float inv_scale, yscale;
    __device__ __forceinline__ void operator()(const f32x4 (&acc)[2][2][4][2], const Unit& u, int wr, int wc, int fr, int fq) const {
        const int row0 = u.pm * BM + wr * 64 + fr, col0 = u.pn * BM + wc * 64 + 8 * fq;
        f32x4 bv[2][2];
#pragma unroll
        for (int bj = 0; bj < 2; ++bj)
#pragma unroll
            for (int n = 0; n < 2; ++n) bv[bj][n] = *(const f32x4*)(bd + (size_t)u.e * 1024 + col0 + bj * 32 + 4 * n);
#pragma unroll
        for (int ai = 0; ai < 2; ++ai)
#pragma unroll
            for (int m = 0; m < 4; ++m) { const int row = row0 + ai * HALF + m * 16; const float gt = rgate[row] * yscale; unsigned char* rowp = Y + (size_t)row * 1024 + col0;
#pragma unroll
                for (int bj = 0; bj < 2; ++bj) { const f32x4 v0 = (acc[ai][bj][m][0] * inv_scale + bv[bj][0]) * gt, v1 = (acc[ai][bj][m][1] * inv_scale + bv[bj][1]) * gt;
                    u32x2 w; w.x = pk4_fp8(v0[0], v0[1], v0[2], v0[3]); w.y = pk4_fp8(v1[0], v1[1], v1[2], v1[3]);
                    *(u32x2*)(rowp + bj * 32) = w; } }
    }
};
struct EpiPle {
    static constexpr bool PERM = true;
    const bf16_t* xin; float* xout; bf16_t* xb; const bf16_t* pp; const float* bgate; float inv_scale;
    __device__ __forceinline__ void operator()(const f32x4 (&acc)[2][2][4][2], const Unit& u, int wr, int wc, int fr, int fq) const {
        const int row0 = u.pm * BM + wr * 64 + fr, col0 = u.pn * BM + wc * 64 + 8 * fq;
        f32x4 bv[2][2];
#pragma unroll
        for (int bj = 0; bj < 2; ++bj)
#pragma unroll
            for (int n = 0; n < 2; ++n) bv[bj][n] = *(const f32x4*)(bgate + col0 + bj * 32 + 4 * n);
#pragma unroll
        for (int ai = 0; ai < 2; ++ai)
#pragma unroll
            for (int m = 0; m < 4; ++m) { const size_t off = (size_t)(row0 + ai * HALF + m * 16) * 1024 + col0;
#pragma unroll
                for (int bj = 0; bj < 2; ++bj) { const size_t o2 = off + bj * 32;
                    const u32x4 xw = *(const u32x4*)(xin + o2); const f32x4 x0 = {bf_lo(xw.x), bf_hi(xw.x), bf_lo(xw.y), bf_hi(xw.y)}, x1 = {bf_lo(xw.z), bf_hi(xw.z), bf_lo(xw.w), bf_hi(xw.w)}; const u32x4 pw = *(const u32x4*)(pp + o2);
                    const f32x4 a0 = acc[ai][bj][m][0] * inv_scale + bv[bj][0], a1 = acc[ai][bj][m][1] * inv_scale + bv[bj][1];
                    f32x4 r0, r1;
                    r0[0] = x0[0] + bf_lo(pw.x) * sigmoidf_fast(a0[0]); r0[1] = x0[1] + bf_hi(pw.x) * sigmoidf_fast(a0[1]);
                    r0[2] = x0[2] + bf_lo(pw.y) * sigmoidf_fast(a0[2]); r0[3] = x0[3] + bf_hi(pw.y) * sigmoidf_fast(a0[3]);
                    r1[0] = x1[0] + bf_lo(pw.z) * sigmoidf_fast(a1[0]); r1[1] = x1[1] + bf_hi(pw.z) * sigmoidf_fast(a1[1]);
                    r1[2] = x1[2] + bf_lo(pw.w) * sigmoidf_fast(a1[2]); r1[3] = x1[3] + bf_hi(pw.w) * sigmoidf_fast(a1[3]);
                    if (xout) { *(f32x4*)(xout + o2) = r0; *(f32x4*)(xout + o2 + 4) = r1; }
                    u32x4 w; w.x = cvt_pk_bf16(r0[0], r0[1]); w.y = cvt_pk_bf16(r0[2], r0[3]); w.z = cvt_pk_bf16(r1[0], r1[1]); w.w = cvt_pk_bf16(r1[2], r1[3]);
                    *(u32x4*)(xb + o2) = w; }
                asm volatile("" ::: "memory"); }
    }
};

template <class Epi, class Sched, bool ALIGN_EPI, bool FP8 = false, bool GATHER = false>
__device__ __forceinline__ void gemm_phase(PG8_LAS unsigned char* lds, const Gemm g, const Sched& S, const Epi& E, const int wave_) {
    int tid_ = tid_of(wave_); asm volatile("" : "+v"(tid_));
    const int tid = tid_, wid = __builtin_amdgcn_readfirstlane(tid >> 6), lane = tid & 63, wr = wid >> 2, wc = wid & 3, fr = lane & 15, fq = lane >> 4;
    constexpr int ES = FP8 ? 1 : 2;
    const int K = g.K, nt = K * ES / (BK * 2);
    unsigned voffA[2], voffB[2]; int Rrow[2]; unsigned Cb[2];
#pragma unroll
    for (int i = 0; i < 2; ++i) { int R, C; stage_rc(tid * 16 + i * 8192, R, C); Rrow[i] = R; Cb[i] = (unsigned)(C * 2); const int Rb = Epi::PERM ? ((R & ~31) + perm32(R & 31)) : R;
        voffA[i] = (unsigned)(R * K * ES + C * 2); voffB[i] = (unsigned)((Epi::PERM ? ((Rb >> 5) * 64 + (Rb & 31)) : Rb) * K * ES + C * 2); }
    const size_t kstep = (size_t)(BK * 2);
    const size_t hstep = (size_t)HALF * K * ES;
    const size_t tstep = 2 * hstep;
    const size_t hstepB = Epi::PERM ? (size_t)32 * K * ES : hstep;
    const unsigned ldsw = (unsigned)wid * 1024u;
    const int aoff = lds_byte(wr * 64 + fr, fq * 8), boff = lds_byte(wc * 32 + fr, fq * 8);
#define PG8_SA(b, h) (((b) * 2 + (h)) * HTB)
#define PG8_SB(b, h) ((4 + (b) * 2 + (h)) * HTB)
#define PG8_STAGE(bufoff, gbase, voff) do { _Pragma("unroll") for (int _i = 0; _i < 2; ++_i) \
        __builtin_amdgcn_global_load_lds((const unsigned*)((const char*)(gbase) + (voff)[_i]), (PG8_LAS unsigned*)(lds + (bufoff) + ldsw + _i * 8192), 16, 0, 0); } while (0)
#define PG8_LDA(dst, b, h) do { _Pragma("unroll") for (int m = 0; m < 4; ++m) { const i32x4 lo_ = *(const PG8_LAS i32x4*)(lds + PG8_SA(b, h) + aoff + m * 2048), hi_ = *(const PG8_LAS i32x4*)(lds + PG8_SA(b, h) + aoff + m * 2048 + 1024); dst[m] = __builtin_shufflevector(lo_, hi_, 0, 1, 2, 3, 4, 5, 6, 7); } } while (0)
#define PG8_LDB(dst, b, h) do { _Pragma("unroll") for (int n = 0; n < 2; ++n) { const i32x4 lo_ = *(const PG8_LAS i32x4*)(lds + PG8_SB(b, h) + boff + n * 2048), hi_ = *(const PG8_LAS i32x4*)(lds + PG8_SB(b, h) + boff + n * 2048 + 1024); dst[n] = __builtin_shufflevector(lo_, hi_, 0, 1, 2, 3, 4, 5, 6, 7); } } while (0)
#define PG8_MMA(ai, bj, At, Bt) do { __builtin_amdgcn_s_setprio(1); _Pragma("unroll") for (int m = 0; m < 4; ++m) _Pragma("unroll") for (int n = 0; n < 2; ++n) { \
        if constexpr (FP8) asm volatile("v_mfma_scale_f32_16x16x128_f8f6f4 %0, %1, %2, %0, %3, %3 op_sel_hi:[0,0,0]" : "+v"(acc[ai][bj][m][n]) : "v"(Bt[n]), "v"(At[m]), "v"(scl1));   \
        else { acc[ai][bj][m][n] = __builtin_amdgcn_mfma_f32_16x16x32_bf16(__builtin_bit_cast(bf16x8, __builtin_shufflevector(Bt[n], Bt[n], 0, 1, 2, 3)), __builtin_bit_cast(bf16x8, __builtin_shufflevector(At[m], At[m], 0, 1, 2, 3)), acc[ai][bj][m][n], 0, 0, 0); \
               acc[ai][bj][m][n] = __builtin_amdgcn_mfma_f32_16x16x32_bf16(__builtin_bit_cast(bf16x8, __builtin_shufflevector(Bt[n], Bt[n], 4, 5, 6, 7)), __builtin_bit_cast(bf16x8, __builtin_shufflevector(At[m], At[m], 4, 5, 6, 7)), acc[ai][bj][m][n], 0, 0, 0); } } \
        __builtin_amdgcn_s_setprio(0); } while (0)
#define PG8_WAIT_V(n) asm volatile("s_waitcnt vmcnt(" #n ")" ::: "memory")
#define PG8_WAIT_L(n) asm volatile("s_waitcnt lgkmcnt(" #n ")" ::: "memory")
#define PG8_BAR __builtin_amdgcn_s_barrier()
#define PG8_SCHED __builtin_amdgcn_sched_barrier(0)
    Unit cur, nxt; int ui = 0;
    if (!S.next(0, cur)) return;
    f32x4 acc[2][2][4][2];
#pragma unroll
    for (int a = 0; a < 2; ++a)
#pragma unroll
        for (int b = 0; b < 2; ++b)
#pragma unroll
            for (int m = 0; m < 4; ++m)
#pragma unroll
                for (int n = 0; n < 2; ++n) acc[a][b][m][n] = (f32x4){0.f, 0.f, 0.f, 0.f};
    int scl1 = 0x7f7f7f7f; asm volatile("" : "+v"(scl1));
    i32x8 At[4], B0[2], B1[2];
    const char* cA = GATHER ? (const char*)g.A : (const char*)g.A + (size_t)cur.pm * tstep; const char* cB = (const char*)g.Bt + (size_t)cur.e * g.bstride * ES + (size_t)cur.pn * tstep;
    unsigned gvC[2][2], gvN[2][2]; int tokN[2][2];
    if constexpr (GATHER) {
#pragma unroll
        for (int h = 0; h < 2; ++h)
#pragma unroll
            for (int i = 0; i < 2; ++i) { gvC[h][i] = (unsigned)g.rowtok[cur.pm * BM + h * HALF + Rrow[i]] * (unsigned)(K * ES) + Cb[i]; gvN[h][i] = gvC[h][i]; tokN[h][i] = 0; }
    }
#define PG8_STAGE_A(bufoff, kptr, h, nx) do { if constexpr (GATHER) { if (nx) PG8_STAGE(bufoff, kptr, gvS[h]); else PG8_STAGE(bufoff, kptr, gvC[h]); } else PG8_STAGE(bufoff, (kptr) + (h) * hstep, voffA); } while (0)
    { unsigned (&gvS)[2][2] = gvC;
    PG8_STAGE(PG8_SB(0, 0), cB, voffB); PG8_STAGE(PG8_SB(0, 1), cB + hstepB, voffB); PG8_STAGE_A(PG8_SA(0, 0), cA, 0, false); PG8_STAGE_A(PG8_SA(0, 1), cA, 1, false);
    if (wr == 1) PG8_BAR;
    PG8_WAIT_V(2); PG8_BAR;
    PG8_STAGE(PG8_SB(1, 0), cB + kstep, voffB); PG8_STAGE_A(PG8_SA(1, 0), cA + kstep, 0, false); PG8_STAGE(PG8_SB(1, 1), cB + hstepB + kstep, voffB); }
    PG8_WAIT_V(6); PG8_BAR;
    for (;;) {
        const bool has_next = S.next(ui + 1, nxt);
        const char* nA = (has_next && !GATHER) ? (const char*)g.A + (size_t)nxt.pm * tstep : cA; const char* nB = has_next ? (const char*)g.Bt + (size_t)nxt.e * g.bstride * ES + (size_t)nxt.pn * tstep : cB;
        if constexpr (GATHER) { if (has_next) {
#pragma unroll
            for (int h = 0; h < 2; ++h)
#pragma unroll
                for (int i = 0; i < 2; ++i) asm volatile("global_load_dword %0, %1, off" : "=v"(tokN[h][i]) : "v"(g.rowtok + nxt.pm * BM + h * HALF + Rrow[i]) : "memory"); } }
#pragma nounroll
        for (int t = 0; t < nt; t += 2) {
            const bool last = (t == nt - 2);
            unsigned gvS[2][2];
            if constexpr (GATHER) {
                if (last && has_next) {
#pragma unroll
                    for (int h = 0; h < 2; ++h)
#pragma unroll
                        for (int i = 0; i < 2; ++i) { int tk_ = tokN[h][i]; asm volatile("" : "+v"(tk_));
                            gvN[h][i] = (unsigned)tk_ * (unsigned)(K * ES) + Cb[i]; }
                }
#pragma unroll
                for (int h = 0; h < 2; ++h)
#pragma unroll
                    for (int i = 0; i < 2; ++i) gvS[h][i] = last ? gvN[h][i] : gvC[h][i];
            }
            const char* a1 = cA + (size_t)(t + 1) * kstep;
            const char* a2 = last ? nA : cA + (size_t)(t + 2) * kstep; const char* b2 = last ? nB : cB + (size_t)(t + 2) * kstep;
            const char* a3 = a2 + kstep; const char* b3 = b2 + kstep;
            PG8_LDB(B0, 0, 0); PG8_LDB(B1, 0, 1); PG8_SCHED; PG8_LDA(At, 0, 0); PG8_STAGE_A(PG8_SA(1, 1), a1, 1, false);
            PG8_WAIT_V(8); PG8_WAIT_L(0); PG8_BAR; PG8_MMA(0, 0, At, B0); PG8_MMA(0, 1, At, B1); PG8_BAR; PG8_SCHED;
            PG8_LDA(At, 0, 1); PG8_STAGE(PG8_SB(0, 0), b2, voffB); PG8_STAGE(PG8_SB(0, 1), b2 + hstepB, voffB); PG8_STAGE_A(PG8_SA(0, 0), a2, 0, true);
            PG8_WAIT_V(8); PG8_WAIT_L(0); PG8_BAR; PG8_MMA(1, 0, At, B0); PG8_MMA(1, 1, At, B1); PG8_BAR; PG8_SCHED;
            PG8_LDB(B0, 1, 0); PG8_LDB(B1, 1, 1); PG8_SCHED; PG8_LDA(At, 1, 0); PG8_STAGE_A(PG8_SA(0, 1), a2, 1, true);
            PG8_WAIT_V(8); PG8_WAIT_L(0); PG8_BAR; PG8_MMA(0, 0, At, B0); PG8_MMA(0, 1, At, B1); PG8_BAR; PG8_SCHED;
            PG8_LDA(At, 1, 1); PG8_STAGE(PG8_SB(1, 0), b3, voffB); PG8_STAGE(PG8_SB(1, 1), b3 + hstepB, voffB); PG8_STAGE_A(PG8_SA(1, 0), a3, 0, true);
            PG8_WAIT_V(8); PG8_WAIT_L(0); PG8_BAR; PG8_MMA(1, 0, At, B0); PG8_MMA(1, 1, At, B1); PG8_BAR; PG8_SCHED;
        }
        if constexpr (ALIGN_EPI) { if (wr == 0) PG8_BAR; }
        if constexpr (FP8) {
            asm volatile("s_nop 15\n\ts_nop 15" : "+v"(acc[0][0][0][0]), "+v"(acc[0][0][0][1]), "+v"(acc[0][0][1][0]), "+v"(acc[0][0][1][1]), "+v"(acc[0][0][2][0]), "+v"(acc[0][0][2][1]), "+v"(acc[0][0][3][0]), "+v"(acc[0][0][3][1]),
                         "+v"(acc[0][1][0][0]), "+v"(acc[0][1][0][1]), "+v"(acc[0][1][1][0]), "+v"(acc[0][1][1][1]), "+v"(acc[0][1][2][0]), "+v"(acc[0][1][2][1]), "+v"(acc[0][1][3][0]), "+v"(acc[0][1][3][1]));
            asm volatile("s_nop 0" : "+v"(acc[1][0][0][0]), "+v"(acc[1][0][0][1]), "+v"(acc[1][0][1][0]), "+v"(acc[1][0][1][1]), "+v"(acc[1][0][2][0]), "+v"(acc[1][0][2][1]), "+v"(acc[1][0][3][0]), "+v"(acc[1][0][3][1]),
                         "+v"(acc[1][1][0][0]), "+v"(acc[1][1][0][1]), "+v"(acc[1][1][1][0]), "+v"(acc[1][1][1][1]), "+v"(acc[1][1][2][0]), "+v"(acc[1][1][2][1]), "+v"(acc[1][1][3][0]), "+v"(acc[1][1][3][1])); }
        E(acc, cur, wr, wc, fr, fq);
        if (!has_next) break;
#pragma unroll
        for (int a = 0; a < 2; ++a)
#pragma unroll
            for (int b = 0; b < 2; ++b)
#pragma unroll
                for (int m = 0; m < 4; ++m)
#pragma unroll
                    for (int n = 0; n < 2; ++n) acc[a][b][m][n] = (f32x4){0.f, 0.f, 0.f, 0.f};
        cur = nxt; cA = nA; cB = nB; ++ui;
        if constexpr (GATHER) {
#pragma unroll
            for (int h = 0; h < 2; ++h)
#pragma unroll
                for (int i = 0; i < 2; ++i) gvC[h][i] = gvN[h][i]; }
        if constexpr (ALIGN_EPI) { if (wr == 1) PG8_BAR; }
    }
    PG8_WAIT_V(0);
    if constexpr (!ALIGN_EPI) { if (wr == 0) PG8_BAR; }
    PG8_BAR;
#undef PG8_SA
#undef PG8_SB
#undef PG8_STAGE
#undef PG8_STAGE_A
#undef PG8_LDA
#undef PG8_LDB
#undef PG8_MMA
#undef PG8_WAIT_V
#undef PG8_WAIT_L
#undef PG8_BAR
#undef PG8_SCHED
}
}

constexpr int NWAVES = 8, NTHR = NWAVES * 64;
constexpr int BATCH = 8, SEQ = 4096, D = 1024, NH = 16, HD = 64, DEPTH = 4, NE = 32, TOPK = 4, PLE = 256;
constexpr int T = BATCH * SEQ;
constexpr float LN_EPS = 1e-5f;
constexpr float DN_ALPHA = 1.6817928305074290f;
constexpr float C2 = 0.125f * 1.4426950408889634f;
constexpr int NR_MAX = T * TOPK + NE * 256;
constexpr int NPH = 1 + 12 * DEPTH;
constexpr float Y_SCALE = 16.0f;
constexpr float WGU_SCALE = 64.0f, WD_SCALE = 128.0f, WPG_SCALE = 32.0f;

constexpr size_t MiB = 1u << 20;
constexpr size_t WS_CTL = 0, CTL_ZERO_BYTES = 1 * MiB;
constexpr size_t WS_WIN = 2 * MiB, WIN_STRIDE = 7 * MiB;
constexpr size_t WS_WOUT = 30 * MiB, WS_WR = 38 * MiB, WS_WPP = 40 * MiB, WS_WPG = 42 * MiB;
constexpr size_t WS_WGU = 64 * MiB, WS_WD = 576 * MiB;
constexpr size_t WS_X = 832 * MiB, WS_XB = 960 * MiB, WS_PB = 1024 * MiB, WS_PP = 1088 * MiB;
constexpr size_t WS_PROJ = 1152 * MiB, PROJ_REGION = 64 * MiB;
constexpr size_t WS_H = WS_PROJ;
constexpr size_t WS_Y = 1424 * MiB;
constexpr size_t WS_MISC = 1696 * MiB;
constexpr size_t WS_LOGITS = WS_MISC, WS_TOKE = WS_MISC + 4 * MiB, WS_TOKG = WS_TOKE + MiB / 2, WS_TOKLP = WS_TOKG + MiB / 2, WS_TOKPOS = WS_TOKLP + MiB / 2,
                 WS_ROWGATE = WS_TOKPOS + MiB / 2, WS_WGOFF = WS_ROWGATE + MiB, WS_CUM = WS_WGOFF + MiB, WS_XB2 = WS_CUM + 2 * MiB, WS_XF8 = WS_XB2 + 64 * MiB, WS_ROWTOK = WS_XF8 + 32 * MiB, WS_END = WS_ROWTOK + MiB;
static_assert(WS_H + (size_t)NR_MAX * 1024 * 2 <= WS_Y && WS_Y + (size_t)NR_MAX * 1024 * 2 <= WS_MISC, "ws map");
constexpr int CW_BAR = 4096;
constexpr int CW_CNT = 16384;

constexpr int RING_OFF = 0, RING_BYTES = 131072;
constexpr int LDSCTL_OFF = RING_BYTES, MISC_OFF = LDSCTL_OFF + 320;
constexpr int TEND_OFF = LDSCTL_OFF + 1024;
constexpr int LDS_BYTES = 147456;

#define GAS __attribute__((address_space(1)))
#define LAS __attribute__((address_space(3)))
typedef unsigned short bf16;
typedef unsigned v4u __attribute__((ext_vector_type(4)));
typedef unsigned v2u __attribute__((ext_vector_type(2)));
typedef float f32x4 __attribute__((ext_vector_type(4)));
typedef float f32x16 __attribute__((ext_vector_type(16)));
typedef float f32x2_ __attribute__((ext_vector_type(2)));
typedef short bf16x8 __attribute__((ext_vector_type(8)));
typedef short s16x4 __attribute__((ext_vector_type(4)));
typedef GAS unsigned gu32;
#define RLX_AGENT __ATOMIC_RELAXED, __HIP_MEMORY_SCOPE_AGENT
#define LDS_WAIT() asm volatile("s_waitcnt lgkmcnt(0)" ::: "memory")
#define VM_WAIT() asm volatile("s_waitcnt vmcnt(0)" ::: "memory")
__device__ __forceinline__ unsigned f2bf(float f) { unsigned u = __builtin_bit_cast(unsigned, f); return (u + 0x7fffu + ((u >> 16) & 1u)) >> 16; }
__device__ __forceinline__ unsigned pk2(float lo, float hi) { return f2bf(lo) | (f2bf(hi) << 16); }
__device__ __forceinline__ float bflo(unsigned w) { return __uint_as_float(w << 16); }
__device__ __forceinline__ float bfhi(unsigned w) { return __uint_as_float(w & 0xffff0000u); }

#define XB_TMO      128
#define XB_XCNT(j)  (256  + 64 * (j))
#define XB_XSUB(j)  (1280 + 64 * (j))
#define XB_XGEN(j)  (2304 + 64 * (j))
#define XB_TOP      3328
#define XB_TOPGEN   3392
#define XCD_BAR_WORDS 3456
#define XB_SPIN_CAP (1u << 18)

__device__ __forceinline__ unsigned xb_ld(unsigned* p)              { return __hip_atomic_load(p, __ATOMIC_RELAXED, __HIP_MEMORY_SCOPE_AGENT); }
__device__ __forceinline__ unsigned xb_add(unsigned* p, unsigned v) { return __hip_atomic_fetch_add(p, v, __ATOMIC_RELAXED, __HIP_MEMORY_SCOPE_AGENT); }
__device__ __forceinline__ unsigned xb_xcc_id() { return (unsigned)__builtin_amdgcn_s_getreg((3 << 11) | 20) & 0xFu; }
#define XB_SPIN(cond, bar) do { unsigned _sp = 0; while (cond) { __builtin_amdgcn_s_sleep(1); \
    if ((++_sp & 255u) == 0u) { if (xb_ld(&(bar)[XB_TMO])) break; if (_sp > XB_SPIN_CAP) { atomicAdd(&(bar)[XB_TMO], 1u); break; } } } } while (0)

struct XcdBarrier { unsigned* bar; unsigned x; volatile LAS unsigned* st; int t0; };

__device__ __forceinline__ XcdBarrier xcd_barrier_post(unsigned* bar, volatile LAS unsigned* st, bool is_t0) {
    XcdBarrier b; b.bar = bar; b.x = xb_xcc_id(); b.st = st; b.t0 = 0;
    if (is_t0) (void)xb_add(&bar[XB_XCNT(b.x)], 1u);
    return b;
}
__device__ __forceinline__ void xcd_barrier_complete(unsigned* bar, unsigned x, unsigned& nloc, unsigned& nx) {
    const unsigned G = gridDim.x * gridDim.y * gridDim.z;
    unsigned sum, cnt, mine, sp = 0u;
    for (;;) {
        sum = 0u; cnt = 0u; mine = 0u;
#pragma unroll
        for (unsigned j = 0; j < 16; ++j) { const unsigned c = xb_ld(&bar[XB_XCNT(j)]); sum += c; cnt += (c > 0u) ? 1u : 0u; mine = (j == x) ? c : mine; }
        if (sum == G) break;
        __builtin_amdgcn_s_sleep(1);
        if ((++sp & 255u) == 0u) { if (xb_ld(&bar[XB_TMO])) break; if (sp > XB_SPIN_CAP) { atomicAdd(&bar[XB_TMO], 1u); break; } }
    }
    nloc = mine > 0u ? mine : 1u; nx = cnt > 0u ? cnt : 1u;
}
__device__ __forceinline__ void xcd_barrier(const XcdBarrier& b, bool is_t0) {
    asm volatile("s_waitcnt vmcnt(0)" ::: "memory");
    __syncthreads();
    if (is_t0) {
        unsigned* bar = b.bar;
        __builtin_amdgcn_s_waitcnt(0);
        unsigned nloc = b.st[0], nx = b.st[1];
        if (nloc == 0u) { xcd_barrier_complete(bar, b.x, nloc, nx); b.st[0] = nloc; b.st[1] = nx; }
        const unsigned old = xb_add(&bar[XB_XSUB(b.x)], 1u);
        const unsigned gen = old / nloc;
        if (old + 1u == (gen + 1u) * nloc) {
            __builtin_amdgcn_fence(__ATOMIC_RELEASE, "agent");
            asm volatile("s_waitcnt vmcnt(0)" ::: "memory");
            const unsigned og = xb_add(&bar[XB_TOP], 1u);
            const unsigned tg = og / nx;
            if (og + 1u == (tg + 1u) * nx) xb_add(&bar[XB_TOPGEN], 1u);
            else XB_SPIN(xb_ld(&bar[XB_TOPGEN]) == tg, bar);
            __builtin_amdgcn_fence(__ATOMIC_ACQUIRE, "agent");
            xb_add(&bar[XB_XGEN(b.x)], 1u);
            asm volatile("s_waitcnt vmcnt(0)" ::: "memory");
        } else {
            XB_SPIN(xb_ld(&bar[XB_XGEN(b.x)]) == gen, bar);
            __builtin_amdgcn_fence(__ATOMIC_ACQUIRE, "agent");
            asm volatile("s_waitcnt vmcnt(0)" ::: "memory");
        }
    }
    __syncthreads();
}

struct Args { const float* in[25]; float* out; unsigned char* ws; int ph_lo, ph_hi; };
struct Frame {
    LAS unsigned char* lds;
    gu32* ctl;
    int tid, lane, wave, vcu, G;
    unsigned char* ws;
};

__device__ __forceinline__ float shfl_f(float v, int src_lane) { return __int_as_float(__builtin_amdgcn_ds_bpermute(src_lane << 2, __float_as_int(v))); }
__device__ __forceinline__ int shfl_i(int v, int src_lane) { return __builtin_amdgcn_ds_bpermute(src_lane << 2, v); }
__device__ __forceinline__ float wave_sum(float v, int lane) {
#pragma unroll
    for (int o = 1; o < 64; o <<= 1) v += shfl_f(v, lane ^ o);
    return v;
}
__device__ __forceinline__ void transpose_item(const float* W, int ldw, int K, bf16* WT, int k0, int n0, int drow0, LAS float* scr, int lane) {
    { const int r_ = lane >> 3, q_ = lane & 7; f32x4 v_[8];
#pragma unroll
      for (int i = 0; i < 8; ++i) v_[i] = *(const GAS f32x4*)(W + (size_t)(k0 + 8 * i + r_) * ldw + n0 + 4 * q_);
#pragma unroll
      for (int i = 0; i < 8; ++i) { LAS float* d_ = scr + (8 * i + r_) * 33 + 4 * q_; d_[0] = v_[i].x; d_[1] = v_[i].y; d_[2] = v_[i].z; d_[3] = v_[i].w; } }
    LDS_WAIT(); asm volatile("" ::: "memory");
    const int c = lane & 7;
#pragma unroll
    for (int j = 0; j < 4; ++j) { const int n = (lane >> 3) + 8 * j; const LAS float* s = scr + (8 * c) * 33 + n;
        v4u o; o.x = pk2(s[0 * 33], s[1 * 33]); o.y = pk2(s[2 * 33], s[3 * 33]); o.z = pk2(s[4 * 33], s[5 * 33]); o.w = pk2(s[6 * 33], s[7 * 33]);
        *(GAS v4u*)(WT + (size_t)(drow0 + n) * K + k0 + 8 * c) = o; }
    LDS_WAIT(); asm volatile("" ::: "memory");
}
struct TileRegs { f32x4 v[8]; };
__device__ __forceinline__ void tile_load(TileRegs& t, const float* W, int ldw, int k0, int n0, int lane) {
    const int r_ = lane >> 3, q_ = lane & 7;
#pragma unroll
    for (int i = 0; i < 8; ++i) t.v[i] = *(const GAS f32x4*)(W + (size_t)(k0 + 8 * i + r_) * ldw + n0 + 4 * q_);
}
__device__ __forceinline__ void tile_store8(const TileRegs& t, int K, unsigned char* WT, int k0, int drow0, float scale, LAS float* scr, int lane) {
    { const int r_ = lane >> 3, q_ = lane & 7;
#pragma unroll
      for (int i = 0; i < 8; ++i) { LAS float* d_ = scr + (8 * i + r_) * 33 + 4 * q_; d_[0] = t.v[i].x; d_[1] = t.v[i].y; d_[2] = t.v[i].z; d_[3] = t.v[i].w; } }
    LDS_WAIT(); asm volatile("" ::: "memory");
    const int c = lane & 7;
#pragma unroll
    for (int j = 0; j < 4; ++j) { const int n = (lane >> 3) + 8 * j; const LAS float* s = scr + (8 * c) * 33 + n;
        v2u o; o.x = pg8::pk4_fp8(s[0 * 33] * scale, s[1 * 33] * scale, s[2 * 33] * scale, s[3 * 33] * scale); o.y = pg8::pk4_fp8(s[4 * 33] * scale, s[5 * 33] * scale, s[6 * 33] * scale, s[7 * 33] * scale);
        *(GAS v2u*)(WT + (size_t)(drow0 + n) * K + k0 + 8 * c) = o; }
    LDS_WAIT(); asm volatile("" ::: "memory");
}
__device__ __forceinline__ int in_vrow0(int L) { return 2048; }

__device__ __forceinline__ void p0_prologue(Frame& F, const Args& a) {
    LAS float* scr = (LAS float*)(F.lds + RING_OFF + F.wave * 16384);
    const int gw = F.vcu * NWAVES + F.wave, NGW = F.G * NWAVES;
    unsigned char* ws = F.ws;
    { constexpr int IT_M8 = 8 * 32, IT_E = 3 * IT_M8, IT_L = NE * IT_E, IT_EXP = DEPTH * IT_L;
      LAS float* sc16 = (LAS float*)(F.lds + F.wave * 16896);
      for (int it = gw; it < IT_EXP; it += NGW) {
          const int L_ = it / IT_L, r_ = it % IT_L, e_ = r_ / IT_E, r2_ = r_ % IT_E, mat_ = r2_ / IT_M8, r3_ = r2_ % IT_M8, kb_ = r3_ / 32, nb_ = r3_ % 32;
          const size_t moff_ = ((size_t)L_ * NE + e_) * (size_t)(D * D); const int k0 = 128 * kb_, n0 = 32 * nb_;
          const float* src; unsigned char* dst; int drow; float sc;
          if (mat_ == 2) { src = a.in[20] + moff_; dst = ws + WS_WD + moff_; drow = n0; sc = WD_SCALE; }
          else { src = a.in[mat_ == 0 ? 16 : 18] + moff_; dst = ws + WS_WGU + 2 * moff_; drow = (n0 >> 7) * 256 + ((n0 & 127) >> 5) * 64 + (mat_ == 1 ? 32 : 0); sc = WGU_SCALE; }
          const int rr = F.lane >> 3, qq = F.lane & 7; f32x4 v[16];
#pragma unroll
          for (int i = 0; i < 16; ++i) v[i] = *(const GAS f32x4*)(src + (size_t)(k0 + 8 * i + rr) * D + n0 + 4 * qq);
#pragma unroll
          for (int i = 0; i < 16; ++i) { const int row = 8 * i + rr; LAS float* d_ = sc16 + row * 33; const int sw = 8 * ((row >> 5) & 3);
              d_[(4 * qq) ^ sw] = v[i].x; d_[(4 * qq + 1) ^ sw] = v[i].y; d_[(4 * qq + 2) ^ sw] = v[i].z; d_[(4 * qq + 3) ^ sw] = v[i].w; }
          LDS_WAIT(); asm volatile("" ::: "memory");
          const int c = F.lane & 7;
#pragma unroll
          for (int j = 0; j < 4; ++j) { const int n = (F.lane >> 3) + 8 * j; const LAS float* s_ = sc16 + (16 * c) * 33 + (n ^ (8 * ((c >> 1) & 3)));
              v4u o; o.x = pg8::pk4_fp8(s_[0 * 33] * sc, s_[1 * 33] * sc, s_[2 * 33] * sc, s_[3 * 33] * sc); o.y = pg8::pk4_fp8(s_[4 * 33] * sc, s_[5 * 33] * sc, s_[6 * 33] * sc, s_[7 * 33] * sc);
              o.z = pg8::pk4_fp8(s_[8 * 33] * sc, s_[9 * 33] * sc, s_[10 * 33] * sc, s_[11 * 33] * sc); o.w = pg8::pk4_fp8(s_[12 * 33] * sc, s_[13 * 33] * sc, s_[14 * 33] * sc, s_[15 * 33] * sc);
              *(GAS v4u*)(dst + (size_t)(drow + n) * D + k0 + 16 * c) = o; }
          LDS_WAIT(); asm volatile("" ::: "memory");
      } }
    __syncthreads();
    constexpr int IT_MAT = 16 * 32;
    for (int it = gw; it < DEPTH * 16 * 96; it += NGW) {
        const int L = it / (16 * 96), r = it % (16 * 96), kb = r / 96, nb = r % 96, n0 = 32 * nb;
        const float* src = (L == 0) ? a.in[2] : (L == 1) ? a.in[5] : (L == 2) ? a.in[7] : a.in[2] + (size_t)D * 3 * D;
        const int ldw = (L == 2) ? 3 * D + NH : 3 * D;
        const int drow0 = (L == 0 || L == 3 || n0 < 2048) ? n0 : in_vrow0(L) + n0 - 2048;
        transpose_item(src, ldw, D, (bf16*)(ws + WS_WIN + (size_t)L * WIN_STRIDE), 64 * kb, n0, drow0, scr, F.lane);
    }
    for (int it = gw; it < 2 * DEPTH * IT_MAT; it += NGW) {
        const int w = it / (DEPTH * IT_MAT), r = it % (DEPTH * IT_MAT), L = r / IT_MAT, r3 = r % IT_MAT, kb = r3 / 32, nb = r3 % 32;
        const float* src; bf16* dst;
        if (w == 0) { src = (L == 0) ? a.in[4] : (L == 1) ? a.in[6] : (L == 2) ? a.in[9] : a.in[4] + (size_t)D * D; dst = (bf16*)(ws + WS_WOUT) + (size_t)L * D * D; }
        else { src = a.in[23] + (size_t)L * D * D; dst = (bf16*)(ws + WS_WPG) + (size_t)L * D * D; }
        if (w == 0) transpose_item(src, D, D, dst, 64 * kb, 32 * nb, 32 * nb, scr, F.lane);
        else { TileRegs tr; tile_load(tr, src, D, 64 * kb, 32 * nb, F.lane); tile_store8(tr, D, ws + WS_WPG + (size_t)L * D * D, 64 * kb, 32 * nb, WPG_SCALE, scr, F.lane); }
    }
    for (int it = gw; it < DEPTH * (128 + 16); it += NGW) {
        const int L = it / 144, r = it % 144;
        if (r < 128) transpose_item(a.in[22] + (size_t)L * PLE * D, D, PLE, (bf16*)(ws + WS_WPP) + (size_t)L * D * PLE, 64 * (r / 32), 32 * (r % 32), 32 * (r % 32), scr, F.lane);
        else transpose_item(a.in[14] + (size_t)L * D * NE, NE, D, (bf16*)(ws + WS_WR) + (size_t)L * 256 * D, 64 * (r - 128), 0, 0, scr, F.lane);
    }
    const size_t gt = (size_t)F.vcu * NTHR + F.tid, NGT = (size_t)F.G * NTHR;
    { bf16* win2 = (bf16*)(ws + WS_WIN + 2 * WIN_STRIDE);
      for (size_t i = gt; i < (size_t)NH * D; i += NGT) { const int c = (int)(i / D), k = (int)(i % D); win2[(size_t)(3072 + c) * D + k] = (bf16)f2bf(a.in[7][(size_t)k * (3 * D + NH) + 3 * D + c]); }
      v4u z = {0u, 0u, 0u, 0u};
      for (size_t i = gt; i < (size_t)(256 - NH) * D / 8; i += NGT) *(GAS v4u*)(win2 + (size_t)(3072 + NH) * D + i * 8) = z;
      for (size_t i = gt; i < (size_t)DEPTH * (256 - NE) * D / 8; i += NGT) { const size_t L = i / ((256 - NE) * D / 8), r = i % ((256 - NE) * D / 8);
          *(GAS v4u*)((bf16*)(ws + WS_WR) + L * 256 * D + (size_t)NE * D + r * 8) = z; } }
    { const float* x = a.in[0]; bf16* xb = (bf16*)(ws + WS_XB2);
      for (size_t i = gt; i < (size_t)T * D / 8; i += NGT) { const f32x4 v0 = *(const GAS f32x4*)(x + i * 8), v1 = *(const GAS f32x4*)(x + i * 8 + 4);
          v4u o; o.x = pk2(v0.x, v0.y); o.y = pk2(v0.z, v0.w); o.z = pk2(v1.x, v1.y); o.w = pk2(v1.z, v1.w); *(GAS v4u*)(xb + i * 8) = o; }
      const float* p = a.in[1]; bf16* pb = (bf16*)(ws + WS_PB);
      for (size_t i = gt; i < (size_t)DEPTH * T * PLE / 8; i += NGT) { const f32x4 v0 = *(const GAS f32x4*)(p + i * 8), v1 = *(const GAS f32x4*)(p + i * 8 + 4);
          v4u o; o.x = pk2(v0.x, v0.y); o.y = pk2(v0.z, v0.w); o.z = pk2(v1.x, v1.y); o.w = pk2(v1.z, v1.w); *(GAS v4u*)(pb + i * 8) = o; } }
}

__device__ __forceinline__ void ln_store(f32x4 (&v)[4], float* orow, bf16* obrow, unsigned char* o8row, const float* g, const float* b, int lane) {
    float s = 0.f;
#pragma unroll
    for (int j = 0; j < 4; ++j) s += (v[j].x + v[j].y) + (v[j].z + v[j].w);
    const float mean = wave_sum(s, lane) * (1.f / D); float s2 = 0.f;
#pragma unroll
    for (int j = 0; j < 4; ++j) { v[j] = v[j] - mean; s2 += (v[j].x * v[j].x + v[j].y * v[j].y) + (v[j].z * v[j].z + v[j].w * v[j].w); }
    const float rstd = 1.f / sqrtf(wave_sum(s2, lane) * (1.f / D) + LN_EPS);
#pragma unroll
    for (int j = 0; j < 4; ++j) { const f32x4 gg = *(const GAS f32x4*)(g + 4 * (64 * j + lane)), bb = *(const GAS f32x4*)(b + 4 * (64 * j + lane));
        const f32x4 y = v[j] * rstd * gg + bb;
        if (orow) *(GAS f32x4*)(orow + 4 * (64 * j + lane)) = y;
        v2u o; o.x = pk2(y.x, y.y); o.y = pk2(y.z, y.w); *(GAS v2u*)(obrow + 4 * (64 * j + lane)) = o;
        if (o8row) *(GAS unsigned*)(o8row + 4 * (64 * j + lane)) = pg8::pk4_fp8(y.x, y.y, y.z, y.w); }
}

__device__ __forceinline__ int crow(int r, int hi) { return (r & 3) + 8 * (r >> 2) + 4 * hi; }
__device__ __forceinline__ void sb_task(int b, int h, int qblk, const bf16* Q, const bf16* Kt, const bf16* Vt, bf16* O, int lane) {
    const int r32 = lane & 31, hi = lane >> 5;
    const int q0 = qblk * 32, tq = q0 + r32;
    const size_t rowb = (size_t)b * SEQ;
    bf16x8 qr[4];
    { const bf16* Qp = Q + (rowb + tq) * D + h * HD + hi * 8;
#pragma unroll
      for (int d0 = 0; d0 < 4; ++d0) qr[d0] = *(const GAS bf16x8*)(Qp + d0 * 16); }
    f32x16 o0, o1;
#pragma unroll
    for (int r = 0; r < 16; ++r) { o0[r] = 0.f; o1[r] = 0.f; }
    const bf16* Kb = Kt + (rowb + r32) * D + h * HD + hi * 8;
    const bf16* Vb = Vt + (size_t)(h * HD + r32) * T + rowb + 4 * hi;
    const int jmax = (q0 + 31) >> 6;
    float rrun = 0.f;
    bf16x8 kA[2][4], kB[2][4];
#pragma unroll
    for (int d0 = 0; d0 < 4; ++d0) { kA[0][d0] = *(const GAS bf16x8*)(Kb + (size_t)(64 * jmax) * D + d0 * 16); kA[1][d0] = *(const GAS bf16x8*)(Kb + (size_t)(64 * jmax + 32) * D + d0 * 16); }
    for (int j = jmax; j >= 0; --j) {
        const int s0 = 64 * j;
        if (j > 0) {
#pragma unroll
            for (int d0 = 0; d0 < 4; ++d0) { kB[0][d0] = *(const GAS bf16x8*)(Kb + (size_t)(s0 - 64) * D + d0 * 16); kB[1][d0] = *(const GAS bf16x8*)(Kb + (size_t)(s0 - 32) * D + d0 * 16); }
        }
        f32x16 p0, p1;
#pragma unroll
        for (int r = 0; r < 16; ++r) { p0[r] = 0.f; p1[r] = 0.f; }
#pragma unroll
        for (int d0 = 0; d0 < 4; ++d0) { p0 = __builtin_amdgcn_mfma_f32_32x32x16_bf16(kA[0][d0], qr[d0], p0, 0, 0, 0); p1 = __builtin_amdgcn_mfma_f32_32x32x16_bf16(kA[1][d0], qr[d0], p1, 0, 0, 0); }
        s16x4 va[2][2][2][2];
#pragma unroll
        for (int c = 0; c < 2; ++c)
#pragma unroll
            for (int m = 0; m < 2; ++m) { const bf16* vp = Vb + s0 + 32 * c + 16 * m;
                va[c][m][0][0] = *(const GAS s16x4*)(vp); va[c][m][0][1] = *(const GAS s16x4*)(vp + 8);
                va[c][m][1][0] = *(const GAS s16x4*)(vp + (size_t)32 * T); va[c][m][1][1] = *(const GAS s16x4*)(vp + (size_t)32 * T + 8); }
        const bool diag = (j == jmax);
        f32x16 s0v, s1v; float gt_[8];
#pragma unroll
        for (int r = 0; r < 16; ++r) {
            const float za = fminf(p0[r], 126.f), zb = fminf(p1[r], 126.f);
            float sa = __builtin_amdgcn_logf(1.0f + __builtin_amdgcn_exp2f(za)), sb = __builtin_amdgcn_logf(1.0f + __builtin_amdgcn_exp2f(zb));
            if (diag) { const int kv = s0 + crow(r, hi); if (kv >= tq) sa = 0.f; if (kv + 32 >= tq) sb = 0.f; }
            s0v[r] = sa; s1v[r] = sb;
        }
#pragma unroll
        for (int a4 = 0; a4 < 4; ++a4) {
            s0v[4 * a4 + 2] += s0v[4 * a4 + 3]; s0v[4 * a4 + 1] += s0v[4 * a4 + 2]; s0v[4 * a4] += s0v[4 * a4 + 1]; gt_[a4] = s0v[4 * a4];
            s1v[4 * a4 + 2] += s1v[4 * a4 + 3]; s1v[4 * a4 + 1] += s1v[4 * a4 + 2]; s1v[4 * a4] += s1v[4 * a4 + 1]; gt_[4 + a4] = s1v[4 * a4];
        }
        float run = 0.f; float offs[8];
#pragma unroll
        for (int i = 7; i >= 0; --i) {
            const float other = shfl_f(gt_[i], lane ^ 32);
            const float hi_tot = hi ? gt_[i] : other, lo_tot = hi ? other : gt_[i];
            offs[i] = hi ? run : run + hi_tot;
            run += hi_tot + lo_tot;
        }
#pragma unroll
        for (int r = 0; r < 16; ++r) {
            float w0 = __builtin_amdgcn_exp2f(p0[r] - s0v[r] - offs[r >> 2] + rrun), w1 = __builtin_amdgcn_exp2f(p1[r] - s1v[r] - offs[4 + (r >> 2)] + rrun);
            if (diag) { const int kv = s0 + crow(r, hi); if (kv >= tq) w0 = 0.f; if (kv + 32 >= tq) w1 = 0.f; }
            p0[r] = w0; p1[r] = w1;
        }
        rrun -= run;
#pragma unroll
        for (int c = 0; c < 2; ++c)
#pragma unroll
            for (int m = 0; m < 2; ++m) {
                v4u pw;
                if (c == 0) { pw.x = pg8::cvt_pk_bf16(p0[8 * m], p0[8 * m + 1]); pw.y = pg8::cvt_pk_bf16(p0[8 * m + 2], p0[8 * m + 3]); pw.z = pg8::cvt_pk_bf16(p0[8 * m + 4], p0[8 * m + 5]); pw.w = pg8::cvt_pk_bf16(p0[8 * m + 6], p0[8 * m + 7]); }
                else { pw.x = pg8::cvt_pk_bf16(p1[8 * m], p1[8 * m + 1]); pw.y = pg8::cvt_pk_bf16(p1[8 * m + 2], p1[8 * m + 3]); pw.z = pg8::cvt_pk_bf16(p1[8 * m + 4], p1[8 * m + 5]); pw.w = pg8::cvt_pk_bf16(p1[8 * m + 6], p1[8 * m + 7]); }
                const bf16x8 pf = __builtin_bit_cast(bf16x8, pw);
                const s16x4 a0 = va[c][m][0][0], a1 = va[c][m][0][1], b0 = va[c][m][1][0], b1 = va[c][m][1][1];
                const bf16x8 vf0 = (bf16x8){a0[0], a0[1], a0[2], a0[3], a1[0], a1[1], a1[2], a1[3]}, vf1 = (bf16x8){b0[0], b0[1], b0[2], b0[3], b1[0], b1[1], b1[2], b1[3]};
                o0 = __builtin_amdgcn_mfma_f32_32x32x16_bf16(vf0, pf, o0, 0, 0, 0);
                o1 = __builtin_amdgcn_mfma_f32_32x32x16_bf16(vf1, pf, o1, 0, 0, 0);
            }
        if (__all(rrun < -200.f)) break;
#pragma unroll
        for (int c = 0; c < 2; ++c)
#pragma unroll
            for (int d0 = 0; d0 < 4; ++d0) kA[c][d0] = kB[c][d0];
    }
    bf16* Op = O + (rowb + tq) * D + h * HD + 4 * hi;
#pragma unroll
    for (int a4 = 0; a4 < 4; ++a4) {
        v2u w0, w1;
        w0.x = pg8::cvt_pk_bf16(o0[4 * a4], o0[4 * a4 + 1]); w0.y = pg8::cvt_pk_bf16(o0[4 * a4 + 2], o0[4 * a4 + 3]);
        w1.x = pg8::cvt_pk_bf16(o1[4 * a4], o1[4 * a4 + 1]); w1.y = pg8::cvt_pk_bf16(o1[4 * a4 + 2], o1[4 * a4 + 3]);
        *(GAS v2u*)(Op + 8 * a4) = w0; *(GAS v2u*)(Op + 32 + 8 * a4) = w1;
    }
}
__device__ __forceinline__ void sb_phase(Frame& F, const bf16* Q, const bf16* Kt, const bf16* Vt, bf16* O) {
    const int gw = F.vcu * NWAVES + F.wave, NGW = F.G * NWAVES;
    for (int vw = gw; vw < BATCH * NH * 16; vw += NGW) {
        const int bh = vw >> 4, w16 = vw & 15;
        for (int i = 0; i < 8; ++i) { const int qblk = (i & 1) ? 16 * i + 15 - w16 : 16 * i + w16; sb_task(bh / NH, bh % NH, qblk, Q, Kt, Vt, O, F.lane); }
    }
}

namespace attn_body {
using bf16=unsigned short;
using f32x4=__attribute__((ext_vector_type(4)))float;
using bf16x8=__attribute__((ext_vector_type(8)))short;
using s16x4=__attribute__((ext_vector_type(4)))short;
using f32x16=__attribute__((ext_vector_type(16)))float;
using u32x4=__attribute__((ext_vector_type(4)))unsigned;
constexpr int BATCH=8,NHEAD=16,SEQ=4096,D=64,DM=NHEAD*D;
constexpr int NW=8,QBLK=32,QB=QBLK*NW,KVBLK=64,NQB=SEQ/QB;
constexpr int ATTN_PITCH=DM, ATTN_UNIT_ROWS=QB;
__device__ __forceinline__ int crow(int r,int hi){return (r&3)+8*(r>>2)+4*hi;}
#define SBAR() __builtin_amdgcn_sched_barrier(0)
__device__ __forceinline__ void cmask(f32x16&p0,f32x16&p1,int jb,int qrel,int hi){
  const float NEG=-INFINITY; int kb=64*jb+4*hi;
  #pragma unroll
  for(int r=0;r<16;++r){int kv=kb+(r&3)+8*(r>>2); if(kv>qrel)p0[r]=NEG; if(kv+32>qrel)p1[r]=NEG;}
}

constexpr int NSLOT=3, SLOTB=8192;
constexpr int LDS_K=0, LDS_V=NSLOT*SLOTB, LDS_WS=2*NSLOT*SLOTB, LDS_OST=LDS_WS+NW*64*4, LDS_NB=LDS_OST+NW*4096+2048, LDS_BYTES=LDS_NB+SEQ*4;
constexpr float C2=0.125f*1.4426950408889634f;
__device__ __forceinline__ void glds16(const void*gsrc,unsigned lds_dst){unsigned keep;
  asm volatile("s_mov_b32 %0, m0\n\ts_mov_b32 m0, %2\n\ts_nop 0\n\tglobal_load_lds_dwordx4 %1, off\n\ts_mov_b32 m0, %0":"=&s"(keep):"v"(gsrc),"s"(lds_dst):"memory");}
__device__ __forceinline__ float max3f(float a,float b,float c){float r;asm("v_max3_f32 %0, %1, %2, %3":"=v"(r):"v"(a),"v"(b),"v"(c));return r;}
__device__ __forceinline__ float max2f(float a,float b){float r;asm("v_max_f32_e32 %0, %1, %2":"=v"(r):"v"(a),"v"(b));return r;}
__device__ __forceinline__ float fadd_s(float a,float b){float r;asm("v_add_f32_e32 %0, %1, %2":"=v"(r):"v"(a),"v"(b));return r;}
__device__ __forceinline__ float fsub_s(float a,float b){float r;asm("v_sub_f32_e32 %0, %1, %2":"=v"(r):"v"(a),"v"(b));return r;}
typedef float f32x2_t __attribute__((ext_vector_type(2))); typedef __bf16 bf16x2_t __attribute__((ext_vector_type(2)));
__device__ __forceinline__ unsigned cvtpk_s(float lo,float hi){f32x2_t v={lo,hi};bf16x2_t b=__builtin_convertvector(v,bf16x2_t);return __builtin_bit_cast(unsigned,b);}
#define WAIT_BAR(N) asm volatile("s_waitcnt vmcnt(" #N ") lgkmcnt(0)\n\ts_barrier":::"memory")

__device__ __forceinline__ void qkt(f32x16&p0,f32x16&p1,const char*Kslot,const bf16x8*qr,const f32x16&c0i,const f32x16&c1i,int r32,int hi){
  const char*kb=Kslot+hi*1024+r32*16;
  #pragma unroll
  for(int d0=0;d0<4;++d0){
    const bf16x8 b0=*reinterpret_cast<const bf16x8*>(kb+d0*2048);
    const bf16x8 b1=*reinterpret_cast<const bf16x8*>(kb+d0*2048+512);
    if(d0==0){p0=__builtin_amdgcn_mfma_f32_32x32x16_bf16(b0,qr[0],c0i,0,0,0);p1=__builtin_amdgcn_mfma_f32_32x32x16_bf16(b1,qr[0],c1i,0,0,0);}
    else{p0=__builtin_amdgcn_mfma_f32_32x32x16_bf16(b0,qr[d0],p0,0,0,0);p1=__builtin_amdgcn_mfma_f32_32x32x16_bf16(b1,qr[d0],p1,0,0,0);}}
}
typedef __attribute__((address_space(3))) const char* lds_cptr;
typedef short v4i16_t __attribute__((ext_vector_type(4)));
__device__ __forceinline__ void kload8(bf16x8*kf,lds_cptr kp){
  kf[0]=*(const __attribute__((address_space(3))) bf16x8*)(kp);      kf[1]=*(const __attribute__((address_space(3))) bf16x8*)(kp+512);
  kf[2]=*(const __attribute__((address_space(3))) bf16x8*)(kp+2048); kf[3]=*(const __attribute__((address_space(3))) bf16x8*)(kp+2560);
  kf[4]=*(const __attribute__((address_space(3))) bf16x8*)(kp+4096); kf[5]=*(const __attribute__((address_space(3))) bf16x8*)(kp+4608);
  kf[6]=*(const __attribute__((address_space(3))) bf16x8*)(kp+6144); kf[7]=*(const __attribute__((address_space(3))) bf16x8*)(kp+6656);
}
__device__ __forceinline__ void kload2(bf16x8*kf,lds_cptr kp,int j){ kf[2*j]=*(const __attribute__((address_space(3))) bf16x8*)(kp+j*2048); kf[2*j+1]=*(const __attribute__((address_space(3))) bf16x8*)(kp+j*2048+512); }
__device__ __forceinline__ s16x4 vtr(lds_cptr p){ return __builtin_bit_cast(s16x4,__builtin_amdgcn_ds_read_tr16_b64_v4i16((__attribute__((address_space(3))) v4i16_t*)p)); }
__device__ __forceinline__ float rowmax(const f32x16&p0,const f32x16&p1){
  float a=max3f(p0[0],p0[1],p1[0]),b=max3f(p0[2],p0[3],p1[1]);a=max3f(a,p1[2],p1[3]);
  #pragma unroll
  for(int r=4;r<16;r+=4){a=max3f(a,p0[r],p0[r+1]);b=max3f(b,p0[r+2],p0[r+3]);a=max3f(a,p1[r],p1[r+1]);b=max3f(b,p1[r+2],p1[r+3]);}
  const float m=max2f(a,b);
  auto rr=__builtin_amdgcn_permlane32_swap(__float_as_uint(m),__float_as_uint(m),false,false);
  return max2f(__uint_as_float(rr[0]),__uint_as_float(rr[1]));
}
__device__ __forceinline__ void pv(f32x16*o,int vb,bf16x8 pa0,bf16x8 pa1,bf16x8 pa2,bf16x8 pa3){
  #pragma unroll
  for(int d0=0;d0<2;++d0){s16x4 lo[4],hi[4];
    #pragma unroll
    for(int ks=0;ks<4;++ks){
      asm volatile("ds_read_b64_tr_b16 %0,%1 offset:%c2":"=&v"(lo[ks]):"v"(vb),"i"(d0*4096+ks*1024):"memory");
      asm volatile("ds_read_b64_tr_b16 %0,%1 offset:%c2":"=&v"(hi[ks]):"v"(vb),"i"(d0*4096+ks*1024+512):"memory");}
    asm volatile("s_waitcnt lgkmcnt(0)":::"memory");SBAR();
    #define PK(k) (bf16x8){lo[k][0],lo[k][1],lo[k][2],lo[k][3],hi[k][0],hi[k][1],hi[k][2],hi[k][3]}
    o[d0]=__builtin_amdgcn_mfma_f32_32x32x16_bf16(pa0,PK(0),o[d0],0,0,0);
    o[d0]=__builtin_amdgcn_mfma_f32_32x32x16_bf16(pa1,PK(1),o[d0],0,0,0);
    o[d0]=__builtin_amdgcn_mfma_f32_32x32x16_bf16(pa2,PK(2),o[d0],0,0,0);
    o[d0]=__builtin_amdgcn_mfma_f32_32x32x16_bf16(pa3,PK(3),o[d0],0,0,0);
    #undef PK
  }
}

#ifndef ATTN_STORE16
#define ATTN_STORE16(p,v) (*(u32x4*)(p)=(v))
#endif
template<int THRL> __device__ __forceinline__ void attn_unit(int b,int h,int qb,const bf16*Q,const bf16*__restrict__ K,const bf16*__restrict__ V,bf16*O,char*shm,const int tid,const int t0){
  const int lane=tid&63,r32=lane&31,hi=lane>>5; const int wid=__builtin_amdgcn_readfirstlane(tid>>6);
  const long rowbase=(long)b*SEQ; const int q0=qb*QB;
  const bf16*Qw=Q+(rowbase+q0+wid*QBLK)*DM+h*D;
  const bf16*Kh=K+(rowbase+(long)t0*KVBLK)*DM+h*D,*Vh=V+(rowbase+(long)t0*KVBLK)*DM+h*D;
  const unsigned lds0=(unsigned)(uintptr_t)shm;
  float*wsf=(float*)(shm+LDS_WS)+wid*64;
  const bf16*ksrc=Kh+(long)lane*DM+wid*8;
  const bf16*vsrc=Vh+(long)(16*(wid&3)+(lane>>2))*DM+(wid>>2)*32+(lane&3)*8;
  const unsigned kdst=lds0+LDS_K+wid*1024, vdst=lds0+LDS_V+wid*1024;
  #define DMA_K(t,slot) glds16(ksrc+(long)(t)*KVBLK*DM,(unsigned)__builtin_amdgcn_readfirstlane(kdst+(slot)))
  #define DMA_V(t,slot) glds16(vsrc+(long)(t)*KVBLK*DM,(unsigned)__builtin_amdgcn_readfirstlane(vdst+(slot)))
  const int vb0=(int)(lds0+LDS_V)+((lane>>4)&1)*32+(lane&3)*8+(4*hi+((lane&15)>>2))*64;
  const char*Kbase=shm+LDS_K; bf16x8 kf[8];
  const lds_cptr shm3=(lds_cptr)shm; const lds_cptr kp0=shm3+LDS_K+hi*1024+r32*16; const lds_cptr vp0=shm3+LDS_V+((lane>>4)&1)*32+(lane&3)*8+(4*hi+((lane&15)>>2))*64;
  const int NT=(q0+QB)/KVBLK-t0;
  DMA_K(0,0);DMA_V(0,0);DMA_K(1,SLOTB);
  bf16x8 qr[4];
  #pragma unroll
  for(int d0=0;d0<4;++d0)qr[d0]=*reinterpret_cast<const bf16x8*>(&Qw[(long)r32*DM+d0*16+hi*8]);
  float mhat=0.f,l_reg=0.f;f32x16 o[2];o[0]=f32x16{};o[1]=f32x16{};float nmh=0.f;
  const int qrel=wid*QBLK+r32;
  const __attribute__((address_space(3))) float* nbt=(const __attribute__((address_space(3))) float*)(shm3+LDS_NB)+64*t0;
  #define MKCB(C0,C1,t) do{ const __attribute__((address_space(3))) float* bp_=nbt+64*(t)+4*hi; _Pragma("unroll") for(int a_=0;a_<4;++a_){ const f32x4 v0_=*(const __attribute__((address_space(3))) f32x4*)(bp_+8*a_), v1_=*(const __attribute__((address_space(3))) f32x4*)(bp_+32+8*a_); _Pragma("unroll") for(int i_=0;i_<4;++i_){ C0[4*a_+i_]=v0_[i_]+nmh; C1[4*a_+i_]=v1_[i_]+nmh; } } }while(0)
  #define CMASK(P0,P1,t) do{int jb_=(t)-(NT-4); if(jb_>=0)cmask(P0,P1,jb_,qrel,hi);}while(0)
  bool resc=false;
  #define START(P0,P1) do{ const float rm=rowmax(P0,P1); resc=false; \
    { const float dl=rm; mhat=fadd_s(mhat,dl); \
      _Pragma("unroll") for(int r=0;r<16;++r){P0[r]=fsub_s(P0[r],dl);P1[r]=fsub_s(P1[r],dl);} \
      nmh=-mhat; } \
    _Pragma("unroll") for(int r=0;r<16;++r)P0[r]=__builtin_amdgcn_exp2f(P0[r]); }while(0)
  #define RESC() do{ if(resc){ asm volatile("s_waitcnt lgkmcnt(0)":::"memory"); \
      _Pragma("unroll") for(int d_=0;d_<2;++d_) _Pragma("unroll") for(int r=0;r<16;++r)o[d_][r]*=wsf[crow(r,hi)]; } }while(0)
  f32x16 pA0,pA1,pB0,pB1;
  int sl_prev=0,sl_cur=0,sl_next=SLOTB;
  #define ROT() do{sl_prev=sl_cur;sl_cur=sl_next;sl_next=(sl_next==(NSLOT-1)*SLOTB)?0:sl_next+SLOTB;}while(0)
  DMA_K(2,2*SLOTB);
  WAIT_BAR(3);
  MKCB(pA0,pA1,0); qkt(pA0,pA1,Kbase,qr,pA0,pA1,r32,hi);asm volatile("s_nop 15\n\ts_nop 7":"+v"(pA0),"+v"(pA1));CMASK(pA0,pA1,0);
  START(pA0,pA1);
  _Pragma("unroll") for(int r=0;r<16;++r)pA1[r]=__builtin_amdgcn_exp2f(pA1[r]);
  WAIT_BAR(0);
  DMA_K(3,0);DMA_V(1,SLOTB);
  ROT();
  kload8(kf,kp0+sl_cur);
  WAIT_BAR(2);
  s16x4 vlo[8],vhi[8]; u32x4 pw0,pw1,pw2,pw3;
  #define PKW(P,B) cvtpk_s(P[B],P[B+1])
  #define PAF(k) __builtin_bit_cast(bf16x8,pw##k)
  #define VFR(i) (bf16x8){vlo[i][0],vlo[i][1],vlo[i][2],vlo[i][3],vhi[i][0],vhi[i][1],vhi[i][2],vhi[i][3]}
  #define PIN(x) asm volatile("":"+v"(x))
  #define MX3(a,b,c) __builtin_fmaxf(__builtin_fmaxf((a),(b)),(c))
  #define GAPA(MF,A0,A1,A2,A3,W0,W1,PW) do{ MF; sacc+=A0; sacc+=A1; sacc+=A2; sacc+=A3; PIN(sacc); W0; W1; PIN(PW); SBAR(); }while(0)
  #define EX(v) __builtin_amdgcn_exp2f(v)
  #define GAPB(MF,X,B) do{ MF; X[B]=EX(X[B]); X[B+1]=EX(X[B+1]); X[B+2]=EX(X[B+2]); X[B+3]=EX(X[B+3]); PIN(X); SBAR(); }while(0)
  #define VRD(i) do{ vlo[i]=vtr(vp_+(((i)>>2)*4096+((i)&3)*1024)); vhi[i]=vtr(vp_+(((i)>>2)*4096+((i)&3)*1024+512)); }while(0)
  #define KRD(G,j) do{ if(G){ kload2(kf,kp0+sl_next,j); SBAR(); } }while(0)
  #define STEP(C0,C1,P0,P1,t,GK,GV,GL) do{ SBAR(); MKCB(C0,C1,t); SBAR(); \
    const lds_cptr vp_=vp0+sl_prev; \
    VRD(0); SBAR(); float sacc=(P0[0]+P0[1]); \
    GAPA(C0=__builtin_amdgcn_mfma_f32_32x32x16_bf16(kf[0],qr[0],C0,0,0,0), P0[2],P0[3],P0[4],P0[5],     pw0[0]=PKW(P0,0), pw0[1]=PKW(P0,2), pw0); \
    VRD(4); SBAR(); GAPA(C1=__builtin_amdgcn_mfma_f32_32x32x16_bf16(kf[1],qr[0],C1,0,0,0), P0[6],P0[7],P0[8],P0[9],     pw0[2]=PKW(P0,4), pw0[3]=PKW(P0,6), pw0); \
    VRD(1); SBAR(); GAPA(C0=__builtin_amdgcn_mfma_f32_32x32x16_bf16(kf[2],qr[1],C0,0,0,0),   P0[10],P0[11],P0[12],P0[13], pw1[0]=PKW(P0,8), pw1[1]=PKW(P0,10), pw1); \
    VRD(5); SBAR(); GAPA(C1=__builtin_amdgcn_mfma_f32_32x32x16_bf16(kf[3],qr[1],C1,0,0,0),   P0[14],P0[15],P1[0],P1[1],   pw1[2]=PKW(P0,12),pw1[3]=PKW(P0,14), pw1); \
    VRD(2); SBAR(); GAPA(C0=__builtin_amdgcn_mfma_f32_32x32x16_bf16(kf[4],qr[2],C0,0,0,0),   P1[2],P1[3],P1[4],P1[5],     pw2[0]=PKW(P1,0), pw2[1]=PKW(P1,2), pw2); \
    VRD(6); SBAR(); GAPA(C1=__builtin_amdgcn_mfma_f32_32x32x16_bf16(kf[5],qr[2],C1,0,0,0),   P1[6],P1[7],P1[8],P1[9],     pw2[2]=PKW(P1,4), pw2[3]=PKW(P1,6), pw2); \
    VRD(3); SBAR(); GAPA(C0=__builtin_amdgcn_mfma_f32_32x32x16_bf16(kf[6],qr[3],C0,0,0,0),   P1[10],P1[11],P1[12],P1[13], pw3[0]=PKW(P1,8), pw3[1]=PKW(P1,10), pw3); \
    VRD(7); SBAR(); GAPA(C1=__builtin_amdgcn_mfma_f32_32x32x16_bf16(kf[7],qr[3],C1,0,0,0),   P1[14],P1[15],0.f,0.f,       pw3[2]=PKW(P1,12),pw3[3]=PKW(P1,14), pw3); \
    l_reg+=sacc; \
    if(GK){DMA_K((t)+3,sl_cur);} if(GV){DMA_V((t)+1,sl_next);} \
    CMASK(C0,C1,t); \
    { float a=MX3(C0[0],C0[1],C1[0]),b=MX3(C0[2],C0[3],C1[1]); a=MX3(a,C1[2],C1[3]); \
      _Pragma("unroll") for(int r=4;r<16;r+=4){a=MX3(a,C0[r],C0[r+1]);b=MX3(b,C0[r+2],C0[r+3]);a=MX3(a,C1[r],C1[r+1]);b=MX3(b,C1[r+2],C1[r+3]);} \
      float rm=__builtin_fmaxf(a,b); { auto rr=__builtin_amdgcn_permlane32_swap(__float_as_uint(rm),__float_as_uint(rm),false,false); rm=__builtin_fmaxf(__uint_as_float(rr[0]),__uint_as_float(rr[1])); } \
      resc=false; \
      if(__builtin_expect(__any(rm>(float)THRL),0)){ const float dl=__builtin_fmaxf(rm,0.f); mhat+=dl; \
        _Pragma("unroll") for(int r=0;r<16;++r){C0[r]-=dl;C1[r]-=dl;} \
        nmh=-mhat; \
        const float f=__builtin_amdgcn_exp2f(-dl); l_reg*=f; if(hi==0)wsf[r32]=f; resc=true; } } \
    SBAR(); \
    GAPB(o[0]=__builtin_amdgcn_mfma_f32_32x32x16_bf16(PAF(0),VFR(0),o[0],0,0,0), C0,0); \
    GAPB(o[1]=__builtin_amdgcn_mfma_f32_32x32x16_bf16(PAF(0),VFR(4),o[1],0,0,0), C0,4); \
    KRD(GL,0); GAPB(o[0]=__builtin_amdgcn_mfma_f32_32x32x16_bf16(PAF(1),VFR(1),o[0],0,0,0), C0,8); \
    KRD(GL,1); GAPB(o[1]=__builtin_amdgcn_mfma_f32_32x32x16_bf16(PAF(1),VFR(5),o[1],0,0,0), C0,12); \
    KRD(GL,2); GAPB(o[0]=__builtin_amdgcn_mfma_f32_32x32x16_bf16(PAF(2),VFR(2),o[0],0,0,0), C1,0); \
    KRD(GL,3); GAPB(o[1]=__builtin_amdgcn_mfma_f32_32x32x16_bf16(PAF(2),VFR(6),o[1],0,0,0), C1,4); \
    GAPB(o[0]=__builtin_amdgcn_mfma_f32_32x32x16_bf16(PAF(3),VFR(3),o[0],0,0,0), C1,8); \
    GAPB(o[1]=__builtin_amdgcn_mfma_f32_32x32x16_bf16(PAF(3),VFR(7),o[1],0,0,0), C1,12); \
    }while(0)
  int t=1;
  #undef CMASK
  #define CMASK(P0,P1,t) do{}while(0)
  for(;t+5<NT;t+=2){
    STEP(pB0,pB1,pA0,pA1,t,true,true,true);     WAIT_BAR(2); RESC(); ROT();
    STEP(pA0,pA1,pB0,pB1,t+1,true,true,true);   WAIT_BAR(2); RESC(); ROT();
  }
  #undef CMASK
  #define CMASK(P0,P1,t) do{int jb_=(t)-(NT-4); if(jb_>=0)cmask(P0,P1,jb_,qrel,hi);}while(0)
  #define ENDW(tt) do{ if((tt)+3<NT){WAIT_BAR(2);} else if((tt)+2<NT){WAIT_BAR(1);} else {WAIT_BAR(0);} }while(0)
  for(;t+1<NT;t+=2){
    STEP(pB0,pB1,pA0,pA1,t,(t+3<NT),(t+1<NT),(t+1<NT));       ENDW(t);   RESC(); ROT();
    STEP(pA0,pA1,pB0,pB1,t+1,(t+4<NT),(t+2<NT),(t+2<NT));     ENDW(t+1); RESC(); ROT();
  }
  STEP(pB0,pB1,pA0,pA1,NT-1,false,false,false); RESC();
  { float sacc=pB0[0]+pB0[1]; _Pragma("unroll") for(int r=2;r<16;++r)sacc+=pB0[r]; _Pragma("unroll") for(int r=0;r<16;++r)sacc+=pB1[r]; l_reg+=sacc;
    pw0=(u32x4){PKW(pB0,0),PKW(pB0,2),PKW(pB0,4),PKW(pB0,6)};pw1=(u32x4){PKW(pB0,8),PKW(pB0,10),PKW(pB0,12),PKW(pB0,14)};pw2=(u32x4){PKW(pB1,0),PKW(pB1,2),PKW(pB1,4),PKW(pB1,6)};pw3=(u32x4){PKW(pB1,8),PKW(pB1,10),PKW(pB1,12),PKW(pB1,14)};
    SBAR(); pv(o,vb0+sl_cur,PAF(0),PAF(1),PAF(2),PAF(3)); }
  #undef PKW
  #undef PAF
  #undef VFR
  #undef PIN
  #undef MX3
  #undef GAPA
  #undef GAPB
  #undef EX
  #undef VRD
  #undef KRD
  #undef STEP
  #undef ENDW
  {auto rr=__builtin_amdgcn_permlane32_swap(__float_as_uint(l_reg),__float_as_uint(l_reg),false,false);l_reg=__uint_as_float(rr[0])+__uint_as_float(rr[1]);}
  if(hi==0)wsf[32+r32]=l_reg;asm volatile("s_waitcnt lgkmcnt(0)":::"memory");
  float rli[16];
  #pragma unroll
  for(int r=0;r<16;++r)rli[r]=__builtin_amdgcn_rcpf(wsf[32+crow(r,hi)]);
  bf16*Ow=O+(rowbase+q0+wid*QBLK)*DM+h*D;
  { bf16*stg=(bf16*)(shm+LDS_OST)+wid*2048;
    #pragma unroll
    for(int r=0;r<16;++r){const int orow=crow(r,hi);
      #pragma unroll
      for(int d0=0;d0<2;++d0)stg[orow*64+d0*32+r32]=(bf16)(cvtpk_s(o[d0][r]*rli[r],0.f)&0xffffu);}
    asm volatile("s_waitcnt lgkmcnt(0)":::"memory");
    #pragma unroll
    for(int i=0;i<4;++i){const int row=i*8+(lane>>3),ch=lane&7; const u32x4 v=*(const u32x4*)(stg+row*64+ch*8); ATTN_STORE16(Ow+(long)row*DM+ch*8,v);} }
  asm volatile("s_waitcnt lgkmcnt(0)\n\ts_barrier":::"memory");
  #undef MKCB
  #undef DMA_K
  #undef DMA_V
  #undef CMASK
  #undef START
  #undef RESC
  #undef ROT
}
constexpr int ATTN_LDS_BYTES=LDS_BYTES;
struct AttnTensors { const bf16* Q; const bf16* K; const bf16* V; bf16* O; };
struct AttnUnit { int bh; int qb; };
struct FoxOrder {
  int vcu,G;
  __device__ __forceinline__ bool next(int i,AttnUnit&u)const{ const int v=vcu+(i>>3)*G; if(v>=BATCH*NHEAD*2)return false; const int ii=i&7,p=v&1; u.bh=v>>1; u.qb=(ii&1)?16-ii-p:ii+p; return true; }
};
template<int THRL=8> __device__ __forceinline__ void fox_phase(char*lds,const AttnTensors&T,const bf16*gate,const float*bfp,const FoxOrder&S,const int wave_){
  for(int v=S.vcu;v<BATCH*NHEAD*2;v+=S.G){
    int tid_=tid_of(wave_); asm volatile("":"+v"(tid_));
    const int lane_=tid_&63, wid_=__builtin_amdgcn_readfirstlane(tid_>>6);
    const int bh=v>>1, b_=bh/NHEAD, h_=bh%NHEAD; float thr;
    { const float bf_=bfp[h_];
      __attribute__((address_space(3))) float* nb=(__attribute__((address_space(3))) float*)((__attribute__((address_space(3))) char*)lds+LDS_NB);
      __attribute__((address_space(3))) float* wt=(__attribute__((address_space(3))) float*)((__attribute__((address_space(3))) char*)lds+LDS_WS);
      const bf16* gp=gate+((size_t)b_*SEQ+8*tid_)*DM+h_;
      float p[8]; float run=0.f;
      _Pragma("unroll") for(int k=0;k<8;++k){ const float z2=(__uint_as_float((unsigned)gp[(size_t)k*DM]<<16)+bf_)*1.4426950408889634f;
        run+=fminf(z2,0.f)-__builtin_amdgcn_logf(1.0f+__builtin_amdgcn_exp2f(-fabsf(z2))); p[k]=run; }
      float inc=run;
      _Pragma("unroll") for(int o=1;o<64;o<<=1){ const float vv=__int_as_float(__builtin_amdgcn_ds_bpermute((lane_-o)<<2,__float_as_int(inc))); if(lane_>=o)inc+=vv; }
      float mq=0.f,mk=0.f;
      for(int k=0;k<8;++k){ const bf16* kp=T.K+((size_t)b_*SEQ+8*tid_+k)*DM+h_*D; const bf16* qp=T.Q+((size_t)b_*SEQ+8*tid_+k)*DM+h_*D; float sq=0.f,sk=0.f;
        _Pragma("unroll") for(int c=0;c<8;++c){ const u32x4 a=*(const u32x4*)(kp+8*c), q=*(const u32x4*)(qp+8*c);
          _Pragma("unroll") for(int e=0;e<4;++e){ const float al=__uint_as_float(a[e]<<16),ah=__uint_as_float(a[e]&0xffff0000u),ql=__uint_as_float(q[e]<<16),qh=__uint_as_float(q[e]&0xffff0000u); sk+=al*al+ah*ah; sq+=ql*ql+qh*qh; } }
        mq=fmaxf(mq,sq); mk=fmaxf(mk,sk); }
      _Pragma("unroll") for(int o=1;o<64;o<<=1){ mq=fmaxf(mq,__int_as_float(__builtin_amdgcn_ds_bpermute((lane_^o)<<2,__float_as_int(mq)))); mk=fmaxf(mk,__int_as_float(__builtin_amdgcn_ds_bpermute((lane_^o)<<2,__float_as_int(mk)))); }
      if(lane_==63) wt[wid_]=inc;
      if(lane_==0){ wt[16+wid_]=mq; wt[24+wid_]=mk; }
      asm volatile("s_waitcnt lgkmcnt(0)\n\ts_barrier":::"memory");
      float base=inc-run;
      _Pragma("unroll") for(int w=0;w<7;++w) if(w<wid_) base+=wt[w];
      _Pragma("unroll") for(int k=0;k<8;++k) nb[8*tid_+k]=-(base+p[k]);
      float aq=0.f,ak=0.f; _Pragma("unroll") for(int w=0;w<8;++w){ aq=fmaxf(aq,wt[16+w]); ak=fmaxf(ak,wt[24+w]); }
      thr=__int_as_float(__builtin_amdgcn_readfirstlane(__float_as_int(152.0f+2.0f*(sqrtf(aq)*sqrtf(ak)*1.01f+0.5f))));
      asm volatile("s_waitcnt vmcnt(0) lgkmcnt(0)\n\ts_barrier":::"memory"); }
    for(int ii=0;ii<8;++ii){
      const int p_=v&1, qb=(ii&1)?16-ii-p_:ii+p_;
      int t0=0;
      { const __attribute__((address_space(3))) float* nb=(const __attribute__((address_space(3))) float*)((const __attribute__((address_space(3))) char*)lds+LDS_NB);
        const float nq=nb[qb*QB]; const int tmax=4*qb;
        while(t0+2<=tmax && nq-nb[64*(t0+2)-1]>thr) t0+=2;
        t0=__builtin_amdgcn_readfirstlane(t0); }
      attn_unit<THRL>(b_,h_,qb,T.Q,T.K,T.V,T.O,lds,tid_,t0); }
  }
}
#undef SBAR
#undef WAIT_BAR
}

__global__ void __launch_bounds__(NTHR, 2) mk_fwd(Args args) {
    extern __shared__ __attribute__((aligned(16))) unsigned char lds[];
    Frame F;
    F.lds = (LAS unsigned char*)lds;
    F.tid = threadIdx.x; F.lane = F.tid & 63; F.wave = __builtin_amdgcn_readfirstlane(F.tid >> 6);
    F.G = gridDim.x; { const int bx = blockIdx.x; F.vcu = (F.G % 8 == 0) ? (bx % 8) * (F.G / 8) + bx / 8 : bx; }
    F.ws = args.ws; unsigned char* ws = args.ws;
    F.ctl = (gu32*)(ws + WS_CTL);
    volatile LAS unsigned* MISC = (volatile LAS unsigned*)(F.lds + MISC_OFF);
    for (int u = F.tid; u < (LDS_BYTES - LDSCTL_OFF) / 4; u += NTHR) ((LAS unsigned*)(F.lds + LDSCTL_OFF))[u] = 0u;
    __syncthreads();
    const int lo = args.ph_lo, hi = args.ph_hi;
    XcdBarrier bar; bar.bar = (unsigned*)(F.ctl + CW_BAR); bar.x = 0; bar.st = nullptr; bar.t0 = 0;
    if (hi - lo > 1) bar = xcd_barrier_post((unsigned*)(F.ctl + CW_BAR), MISC + 8, F.tid == 0);
#define FRESH() do { int t_ = tid_of(F.wave); asm volatile("" : "+v"(t_)); F.tid = t_; F.lane = t_ & 63; unsigned char* w_ = args.ws; asm volatile("" : "+s"(w_)); ws = w_; F.ws = w_; } while (0)
#define IN(k) (lo <= (k) && (k) < hi)
#define SEAM(k) do { if (IN(k) && IN((k) + 1)) xcd_barrier(bar, F.wave == 0 && lane_id_() == 0); } while (0)
    const int gw = F.vcu * NWAVES + F.wave, NGW = F.G * NWAVES;
    LAS int* tend = (LAS int*)(F.lds + TEND_OFF); LAS int* tbase = tend + 32;

#define XB ((bf16*)(ws + WS_XB))
#define XB2 ((bf16*)(ws + WS_XB2))
#define PP ((bf16*)(ws + WS_PP))
#define R0 ((bf16*)(ws + WS_PROJ))
#define R1 ((bf16*)(ws + WS_PROJ + PROJ_REGION))
#define R2 ((bf16*)(ws + WS_PROJ + 2 * PROJ_REGION))
#define R3 ((bf16*)(ws + WS_PROJ + 3 * PROJ_REGION))
#define HB ((bf16*)(ws + WS_H))
#define YB ((bf16*)(ws + WS_Y))
#define LOGITS ((float*)(ws + WS_LOGITS))
#define TOKE ((int*)(ws + WS_TOKE))
#define TOKG ((float*)(ws + WS_TOKG))
#define TOKLP ((int*)(ws + WS_TOKLP))
#define TOKPOS ((int*)(ws + WS_TOKPOS))
#define ROWGATE ((float*)(ws + WS_ROWGATE))
#define WGOFF ((int*)(ws + WS_WGOFF))
#define CUM ((float*)(ws + WS_CUM))
#define XF8 (ws + WS_XF8)
#define ROWTOK ((int*)(ws + WS_ROWTOK))
#define Y8 (ws + WS_Y)
#define H8 (ws + WS_H)

    if (IN(0)) { FRESH(); p0_prologue(F, args); __syncthreads();
        for (int u = F.tid; u < (LDS_BYTES - LDSCTL_OFF) / 4; u += NTHR) ((LAS unsigned*)(F.lds + LDSCTL_OFF))[u] = 0u;
        __syncthreads(); }
    SEAM(0);

    for (int L = 0; L < DEPTH; ++L) {
        const int kind = (L == 3) ? 0 : L;
        const int P = 1 + 12 * L;
#define gcnt ((gu32*)(ws + WS_CTL) + CW_CNT + 32 * 64 * L)

        if (IN(P + 0)) { FRESH();
            const int npass = (kind == 1) ? 3 : 2;
            for (int pass = 0; pass < npass; ++pass) {
                pg8::Gemm g; pg8::EpiBf16 E; pg8::StaticOrder S; int Mg, Ng;
                if (pass == 0) {
                    Mg = T; Ng = (kind == 0) ? 3 * D : (kind == 1 ? 2 * D : 3 * D + 256);
                    g = pg8::Gemm{XB2, (const bf16*)(ws + WS_WIN + (size_t)L * WIN_STRIDE), D, 0}; E = pg8::EpiBf16{R0, D, D, PROJ_REGION / 2, (kind == 0) ? 1.0f : C2};
                } else if (pass == 1) {
                    Mg = T; Ng = D;
                    g = pg8::Gemm{(const bf16*)(ws + WS_PB) + (size_t)L * T * PLE, (const bf16*)(ws + WS_WPP) + (size_t)L * D * PLE, PLE, 0}; E = pg8::EpiBf16{PP, D, 0, 0, 1.0f};
                } else {
                    Mg = D; Ng = T;
                    g = pg8::Gemm{(const bf16*)(ws + WS_WIN + (size_t)L * WIN_STRIDE) + (size_t)in_vrow0(L) * D, XB2, D, 0}; E = pg8::EpiBf16{R3, T, 0, 0, 1.0f};
                }
                S.init(Mg, Ng, F.G, (int)blockIdx.x);
                pg8::gemm_phase<pg8::EpiBf16, pg8::StaticOrder, true>(F.lds + RING_OFF, g, S, E, F.wave);
            }
        }
        SEAM(P + 0);


        if (IN(P + 2)) { {
            if (kind == 0) { FRESH();
                const float* cw = args.in[3] + (size_t)(L == 3 ? 1 : 0) * 3 * D;
                const int cg = F.tid & 127, rg = F.tid >> 7, ch = cg * 8;
                float w0[8], w1[8], w2[8];
#pragma unroll
                for (int i = 0; i < 8; ++i) { w0[i] = cw[ch + i]; w1[i] = cw[D + ch + i]; w2[i] = cw[2 * D + ch + i]; }
                for (int blk = F.vcu; blk < T / 64; blk += F.G) {
                    const int t0 = blk * 64 + rg * 16;
                    float u1[8], u2[8];
                    if ((t0 & (SEQ - 1)) == 0) {
#pragma unroll
                        for (int i = 0; i < 8; ++i) { u1[i] = 0.f; u2[i] = 0.f; }
                    } else {
                        const v4u c1 = *(const GAS v4u*)(R1 + (size_t)(t0 - 1) * D + ch), h1 = *(const GAS v4u*)(R2 + (size_t)(t0 - 1) * D + ch);
                        const v4u c2 = *(const GAS v4u*)(R1 + (size_t)(t0 - 2) * D + ch), h2 = *(const GAS v4u*)(R2 + (size_t)(t0 - 2) * D + ch);
#pragma unroll
                        for (int i = 0; i < 4; ++i) { u1[2 * i] = bflo(c1[i]) * bflo(h1[i]); u1[2 * i + 1] = bfhi(c1[i]) * bfhi(h1[i]); u2[2 * i] = bflo(c2[i]) * bflo(h2[i]); u2[2 * i + 1] = bfhi(c2[i]) * bfhi(h2[i]); }
                    }
                    for (int r = 0; r < 16; ++r) {
                        const size_t off = (size_t)(t0 + r) * D + ch;
                        const v4u bv = *(const GAS v4u*)(R0 + off), cv = *(const GAS v4u*)(R1 + off), hv = *(const GAS v4u*)(R2 + off);
                        float u0[8], o[8];
#pragma unroll
                        for (int i = 0; i < 4; ++i) { u0[2 * i] = bflo(cv[i]) * bflo(hv[i]); u0[2 * i + 1] = bfhi(cv[i]) * bfhi(hv[i]); }
#pragma unroll
                        for (int i = 0; i < 4; ++i) {
                            o[2 * i] = bflo(bv[i]) * (w0[2 * i] * u2[2 * i] + w1[2 * i] * u1[2 * i] + w2[2 * i] * u0[2 * i]);
                            o[2 * i + 1] = bfhi(bv[i]) * (w0[2 * i + 1] * u2[2 * i + 1] + w1[2 * i + 1] * u1[2 * i + 1] + w2[2 * i + 1] * u0[2 * i + 1]); }
                        v4u ov; ov.x = pk2(o[0], o[1]); ov.y = pk2(o[2], o[3]); ov.z = pk2(o[4], o[5]); ov.w = pk2(o[6], o[7]);
                        *(GAS v4u*)(XB + off) = ov;
#pragma unroll
                        for (int i = 0; i < 8; ++i) { u2[i] = u1[i]; u1[i] = u0[i]; }
                    }
                }
            } else if (kind == 1) { FRESH();
                sb_phase(F, R0, R1, R3, XB);
            } else {
                const attn_body::AttnTensors AT{R0, R1, R2, XB}; const attn_body::FoxOrder FO{F.vcu, F.G};
                attn_body::fox_phase<32>((char*)lds + RING_OFF, AT, R3, args.in[8], FO, F.wave);
            }
        } }
        SEAM(P + 2);

        if (IN(P + 3)) { FRESH();
            pg8::Gemm g{XB, (const bf16*)(ws + WS_WOUT) + (size_t)L * D * D, D, 0}; pg8::StaticOrder S; S.init(T, D, F.G, (int)blockIdx.x);
            pg8::EpiResBf16 E{XB2, R0, D, DN_ALPHA};
            pg8::gemm_phase<pg8::EpiResBf16, pg8::StaticOrder, true>(F.lds + RING_OFF, g, S, E, F.wave);
        }
        SEAM(P + 3);

        if (IN(P + 4)) { FRESH();
            const float* g1 = args.in[10] + (size_t)L * D; const float* b1 = args.in[11] + (size_t)L * D;
            for (int m = gw; m < T; m += 4 * NGW) { v2u yy[4][4];
#pragma unroll
                for (int q = 0; q < 4; ++q)
#pragma unroll
                    for (int j = 0; j < 4; ++j) yy[q][j] = *(const GAS v2u*)(R0 + (size_t)(m + q * NGW) * D + 4 * (64 * j + F.lane));
#pragma unroll
                for (int q = 0; q < 4; ++q) { f32x4 v[4];
#pragma unroll
                    for (int j = 0; j < 4; ++j) v[j] = (f32x4){bflo(yy[q][j].x), bfhi(yy[q][j].x), bflo(yy[q][j].y), bfhi(yy[q][j].y)};
                    ln_store(v, nullptr, XB + (size_t)(m + q * NGW) * D, XF8 + (size_t)(m + q * NGW) * D, g1, b1, F.lane); } }
        }
        SEAM(P + 4);

        if (IN(P + 5)) { FRESH();
            LAS float* part = (LAS float*)(F.lds + RING_OFF);
            LAS int* hist = (LAS int*)(F.lds + RING_OFF + 2 * 128 * 33 * 4);
            const float* rb = args.in[15] + (size_t)L * NE;
            const int rbk = F.wave & 3, kh = F.wave >> 2, r32 = F.lane & 31, hi = F.lane >> 5;
            for (int tb = F.vcu; tb < T / 128; tb += F.G) {
                if (F.tid < 32) hist[F.tid] = 0;
                {
                  const bf16* ap = (const bf16*)(ws + WS_WR) + (size_t)L * 256 * D + (size_t)r32 * D + 512 * kh + 8 * hi;
                  const bf16* bp = XB + (size_t)(tb * 128 + 32 * rbk + r32) * D + 512 * kh + 8 * hi;
                  f32x16 acc;
#pragma unroll
                  for (int r = 0; r < 16; ++r) acc[r] = 0.f;
#pragma unroll 8
                  for (int kk = 0; kk < 32; ++kk) { const bf16x8 a_ = *(const GAS bf16x8*)(ap + 16 * kk), b_ = *(const GAS bf16x8*)(bp + 16 * kk); acc = __builtin_amdgcn_mfma_f32_32x32x16_bf16(a_, b_, acc, 0, 0, 0); }
#pragma unroll
                  for (int r = 0; r < 16; ++r) part[(kh * 128 + 32 * rbk + r32) * 33 + crow(r, hi)] = acc[r]; }
                __syncthreads();
                if (F.tid < 128) {
                    const int t = tb * 128 + F.tid; float v[32];
#pragma unroll
                    for (int j = 0; j < 32; ++j) v[j] = part[F.tid * 33 + j] + part[(128 + F.tid) * 33 + j] + rb[j];
                    int ek[4]; float vk[4];
#pragma unroll
                    for (int k = 0; k < 4; ++k) { float best = v[0]; int bi = 0;
#pragma unroll
                        for (int j = 1; j < 32; ++j) if (v[j] > best) { best = v[j]; bi = j; }
#pragma unroll
                        for (int j = 0; j < 32; ++j) if (j == bi) v[j] = -INFINITY;
                        ek[k] = bi; vk[k] = best; }
                    float ex[4], se = 0.f;
#pragma unroll
                    for (int k = 0; k < 4; ++k) { ex[k] = expf(vk[k] - vk[0]); se += ex[k]; }
                    const float inv = 1.0f / se;
#pragma unroll
                    for (int k = 0; k < 4; ++k) { const int lp = __hip_atomic_fetch_add(hist + ek[k], 1, __ATOMIC_RELAXED, __HIP_MEMORY_SCOPE_WORKGROUP);
                        TOKE[t * 4 + k] = ek[k]; TOKG[t * 4 + k] = ex[k] * inv; TOKLP[t * 4 + k] = lp; }
                }
                __syncthreads();
                if (F.tid < 32) { const int c = hist[F.tid]; const unsigned off = __hip_atomic_fetch_add(gcnt + 64 * F.tid, (unsigned)c, RLX_AGENT); WGOFF[tb * 32 + F.tid] = (int)off; }
                __syncthreads();
            }
        }
        SEAM(P + 5);

        const bool need_tab = IN(P + 7) || IN(P + 8) || IN(P + 9);
        if (need_tab) { FRESH();
            if (F.tid < 64) { const int c = (F.lane < 32) ? (int)__hip_atomic_load(gcnt + 64 * (F.lane & 31), RLX_AGENT) : 0; const int tl = (c + 255) >> 8; int inc = tl;
#pragma unroll
                for (int o = 1; o < 32; o <<= 1) { const int v = shfl_i(inc, F.lane - o); if (F.lane >= o) inc += v; }
                if (F.lane < 32) { tend[F.lane] = inc; tbase[F.lane] = (inc - tl) * 256; } }
            __syncthreads();
        }
        if (IN(P + 7)) { { FRESH();
            for (int tb = F.vcu; tb < T / 128; tb += F.G) {
                { const int t = tb * 128 + (F.tid >> 2), k = F.tid & 3; const int e = TOKE[t * 4 + k];
                  const int row = tbase[e] + WGOFF[tb * 32 + e] + TOKLP[t * 4 + k];
                  ROWGATE[row] = TOKG[t * 4 + k]; TOKPOS[t * 4 + k] = row; ROWTOK[row] = t; }
                if (tb < NE) {
                    const int c = (int)__hip_atomic_load(gcnt + 64 * tb, RLX_AGENT), r0 = tbase[tb] + c, r1 = tbase[tb] + ((c + 255) & ~255);
                    for (int r = r0 + F.tid; r < r1; r += NTHR) ROWTOK[r] = 0; }
            }
        } }
        SEAM(P + 7);

        if (IN(P + 8)) { {
            pg8::Gemm g{(const bf16*)XF8, (const bf16*)(ws + WS_WGU + (size_t)L * NE * 2 * D * D), D, (size_t)2 * D * D, ROWTOK}; FRESH(); pg8::MoeOrder S; S.init(tend[31], 2 * D, F.G, (int)blockIdx.x, tend + (F.lane & 31));
            pg8::EpiSwiglu E{H8, args.in[17] + (size_t)L * NE * D, args.in[19] + (size_t)L * NE * D, 1.0f / WGU_SCALE};
            pg8::gemm_phase<pg8::EpiSwiglu, pg8::MoeOrder, true, true, true>(F.lds + RING_OFF, g, S, E, F.wave);
        } }
        SEAM(P + 8);

        if (IN(P + 9)) { {
            pg8::Gemm g{(const bf16*)H8, (const bf16*)(ws + WS_WD + (size_t)L * NE * D * D), D, (size_t)D * D}; FRESH(); pg8::MoeOrder S; S.init(tend[31], D, F.G, (int)blockIdx.x, tend + (F.lane & 31));
            pg8::EpiDown E{Y8, args.in[21] + (size_t)L * NE * D, ROWGATE, 1.0f / WD_SCALE, Y_SCALE};
            pg8::gemm_phase<pg8::EpiDown, pg8::MoeOrder, true, true>(F.lds + RING_OFF, g, S, E, F.wave);
        } }
        SEAM(P + 9);

        if (IN(P + 10)) { FRESH();
            const float* g2 = args.in[12] + (size_t)L * D; const float* b2 = args.in[13] + (size_t)L * D;
            for (int m = gw; m < T; m += 2 * NGW) { const int m2 = m + NGW; f32x4 v[4], w[4];
                int pos[4], pos2[4];
#pragma unroll
                for (int k = 0; k < 4; ++k) { pos[k] = TOKPOS[m * 4 + k]; pos2[k] = TOKPOS[m2 * 4 + k]; }
                v2u xa[4], xb_[4]; unsigned ya[4][4], yb[4][4];
#pragma unroll
                for (int j = 0; j < 4; ++j) { xa[j] = *(const GAS v2u*)(XB + (size_t)m * D + 4 * (64 * j + F.lane)); xb_[j] = *(const GAS v2u*)(XB + (size_t)m2 * D + 4 * (64 * j + F.lane));
#pragma unroll
                    for (int k = 0; k < 4; ++k) { ya[j][k] = *(const GAS unsigned*)(Y8 + (size_t)pos[k] * D + 4 * (64 * j + F.lane)); yb[j][k] = *(const GAS unsigned*)(Y8 + (size_t)pos2[k] * D + 4 * (64 * j + F.lane)); } }
#pragma unroll
                for (int j = 0; j < 4; ++j) { v[j] = (f32x4){bflo(xa[j].x), bfhi(xa[j].x), bflo(xa[j].y), bfhi(xa[j].y)} * DN_ALPHA; w[j] = (f32x4){bflo(xb_[j].x), bfhi(xb_[j].x), bflo(xb_[j].y), bfhi(xb_[j].y)} * DN_ALPHA;
#pragma unroll
                    for (int k = 0; k < 4; ++k) { const f32x2_ a0 = __builtin_amdgcn_cvt_pk_f32_fp8((int)ya[j][k], false), a1 = __builtin_amdgcn_cvt_pk_f32_fp8((int)ya[j][k], true), c0 = __builtin_amdgcn_cvt_pk_f32_fp8((int)yb[j][k], false), c1 = __builtin_amdgcn_cvt_pk_f32_fp8((int)yb[j][k], true);
                        v[j].x += a0[0] * (1.0f / Y_SCALE); v[j].y += a0[1] * (1.0f / Y_SCALE); v[j].z += a1[0] * (1.0f / Y_SCALE); v[j].w += a1[1] * (1.0f / Y_SCALE);
                        w[j].x += c0[0] * (1.0f / Y_SCALE); w[j].y += c0[1] * (1.0f / Y_SCALE); w[j].z += c1[0] * (1.0f / Y_SCALE); w[j].w += c1[1] * (1.0f / Y_SCALE); } }
                ln_store(v, nullptr, XB + (size_t)m * D, XF8 + (size_t)m * D, g2, b2, F.lane);
                ln_store(w, nullptr, XB + (size_t)m2 * D, XF8 + (size_t)m2 * D, g2, b2, F.lane); }
        }
        SEAM(P + 10);

        if (IN(P + 11)) { FRESH();
            pg8::Gemm g{(const bf16*)XF8, (const bf16*)(ws + WS_WPG + (size_t)L * D * D), D, 0}; pg8::StaticOrder S; S.init(T, D, F.G, (int)blockIdx.x);
            pg8::EpiPle E{XB, (L == DEPTH - 1) ? args.out : nullptr, XB2, PP, args.in[24] + (size_t)L * D, 1.0f / WPG_SCALE};
            pg8::gemm_phase<pg8::EpiPle, pg8::StaticOrder, true, true>(F.lds + RING_OFF, g, S, E, F.wave);
        }
        SEAM(P + 11);
    }
#undef IN
#undef SEAM
#undef gcnt
}

extern "C" void kernel_launch(void* const* d_in, const int* in_sizes, int n_in, void* d_out, int out_size, void* d_ws, size_t ws_size, hipStream_t stream) {
    static int grid = 0;
    if (grid == 0) {
        if (n_in != 25 || in_sizes[0] != T * D || out_size != T * D || ws_size < WS_END) { fprintf(stderr, "kernel_launch: unexpected shapes (n_in %d, in0 %d, out %d, ws %zu < %zu); nothing launched\n", n_in, n_in > 0 ? in_sizes[0] : -1, out_size, ws_size, (size_t)WS_END); grid = -1; return; }
        int dev = 0, cus = 0, per_cu = 0;
        if (hipGetDevice(&dev) != hipSuccess || hipDeviceGetAttribute(&cus, hipDeviceAttributeMultiprocessorCount, dev) != hipSuccess) { grid = -1; return; }
        if (hipFuncSetAttribute((const void*)mk_fwd, hipFuncAttributeMaxDynamicSharedMemorySize, LDS_BYTES) != hipSuccess) { fprintf(stderr, "kernel_launch: hipFuncSetAttribute failed\n"); grid = -1; return; }
        if (hipOccupancyMaxActiveBlocksPerMultiprocessor(&per_cu, (const void*)mk_fwd, NTHR, LDS_BYTES) != hipSuccess || per_cu < 1) fprintf(stderr, "kernel_launch: occupancy query reports %d\n", per_cu);
        (void)hipGetLastError();
        grid = cus;
    }
    if (grid < 0) return;
    if (hipMemsetAsync((char*)d_ws + WS_CTL, 0, CTL_ZERO_BYTES, stream) != hipSuccess) { fprintf(stderr, "kernel_launch: memset failed\n"); return; }
    Args a{};
    for (int i = 0; i < 25; ++i) a.in[i] = (const float*)d_in[i];
    a.out = (float*)d_out; a.ws = (unsigned char*)d_ws;
#if MK_PER_PHASE
    for (int ph = 0; ph < NPH; ++ph) { a.ph_lo = ph; a.ph_hi = ph + 1; hipLaunchKernelGGL(mk_fwd, dim3(grid), dim3(NTHR), LDS_BYTES, stream, a); }
#else
    a.ph_lo = 0; a.ph_hi = NPH;
    hipLaunchKernelGGL(mk_fwd, dim3(grid), dim3(NTHR), LDS_BYTES, stream, a);
#endif
    const hipError_t le = hipPeekAtLastError();
    if (le != hipSuccess) fprintf(stderr, "kernel_launch: launch failed: %s\n", hipGetErrorName(le));
}
```
